# Optimizing an MI355X kernel written in HIP

```python
import math
import jax, jax.numpy as jnp
from jax import lax
import numpy as np

D_MODEL = 2048
BATCH = 16
SEQ = 256
DEPTH = 2
DEC_BATCH = 8
DEC_SEQ = 1024
PAST_LEN = 512

GRID_W = 64
N_EVEN = (DEPTH + 1) // 2
N_ODD = DEPTH // 2
EPS = 1e-6
N_MOD = 9
D_FF = 5632
POOL_WINDOWS = (2, 4, 8, 16)
N_POOL_GROUPS = 4
POOL_WIDTH = D_MODEL // 2
POOL_GROUP_DIM = POOL_WIDTH // N_POOL_GROUPS
HEAD_DIM = 128
N_Q_HEADS = (D_MODEL // 2) // HEAD_DIM
N_KV_HEADS = 2
Q_PER_KV = N_Q_HEADS // N_KV_HEADS
ATTN_WIDTH = N_Q_HEADS * HEAD_DIM
KV_WIDTH = N_KV_HEADS * HEAD_DIM
MIX_IN = POOL_WIDTH + ATTN_WIDTH + 2 * KV_WIDTH
MIX_OUT = POOL_WIDTH + ATTN_WIDTH
Q_BLOCK = 128
ROPE_THETA = 10000.0
D_INNER = 2 * D_MODEL
SSM_HEADDIM = 64
SSM_HEADS = D_INNER // SSM_HEADDIM
SSM_GROUPS = 8
HEADS_PER_GROUP = SSM_HEADS // SSM_GROUPS
D_STATE = 128
D_CONV = 3
SSM_CHUNK = 128
CONV_DIM = D_INNER + 2 * SSM_GROUPS * D_STATE
SSM_IN = D_INNER + CONV_DIM + 2 * SSM_HEADS

kernel_name = "hybrid_pool_gqa_ssd_diffusion_step"

F32 = jnp.float32


def rmsnorm(x, g):
    x32 = x.astype(F32)
    r = x32 * lax.rsqrt(jnp.mean(x32 * x32, axis=-1, keepdims=True) + EPS)
    return (r * g.astype(F32)).astype(x.dtype)


def modulate_in(h, g_pre, shift, scale):
    return rmsnorm(h, g_pre) * (1 + scale[:, None]) + shift[:, None]


def residual_add(h, y, g_post, gate, w):
    return h + w * gate[:, None] * rmsnorm(y, g_post)


def swiglu(u, w_in, w_out):
    a, b = jnp.split(u @ w_in, 2, axis=-1)
    return (jax.nn.silu(a) * b) @ w_out


def pool_mixer(xp, pool_w_l, pool_scale_l):
    b, L, _ = xp.shape
    x32 = xp.astype(F32)
    cs = jnp.concatenate([jnp.zeros((b, 1, POOL_WIDTH), F32), jnp.cumsum(x32, axis=1)], axis=1)
    cs = cs.reshape(b, L + 1, N_POOL_GROUPS, POOL_GROUP_DIM)
    xg = x32.reshape(b, L, N_POOL_GROUPS, POOL_GROUP_DIM)
    t = jnp.arange(L)
    outs = []
    for gi, w in enumerate(POOL_WINDOWS):
        lo = jnp.clip(t - w // 2, 0, L)
        hi = jnp.clip(t - w // 2 + w, 0, L)
        s = cs[:, hi, gi] - cs[:, lo, gi]
        mean = s / (hi - lo).astype(F32)[None, :, None]
        outs.append(mean - xg[:, :, gi])
    d = jnp.stack(outs, axis=2).astype(xp.dtype)
    y = jnp.einsum('blgc,gcd->blgd', d, pool_w_l).reshape(b, L, POOL_WIDTH)
    return y * pool_scale_l


def rope_2d(x):
    L = x.shape[1]
    rows = L // GRID_W
    row = jnp.repeat(jnp.arange(rows), GRID_W).astype(F32)
    col = jnp.tile(jnp.arange(GRID_W), rows).astype(F32)
    half = HEAD_DIM // 2
    quarter = half // 2
    inv_freq = ROPE_THETA ** (-jnp.arange(quarter, dtype=F32) / quarter)

    def rot(xh, pos):
        ang = pos[:, None] * inv_freq[None]
        cos = jnp.cos(ang)[None, :, None]
        sin = jnp.sin(ang)[None, :, None]
        x1, x2 = xh[..., :quarter], xh[..., quarter:]
        return jnp.concatenate([x1 * cos - x2 * sin, x2 * cos + x1 * sin], axis=-1)

    x32 = x.astype(F32)
    return jnp.concatenate([rot(x32[..., :half], row), rot(x32[..., half:], col)], axis=-1).astype(x.dtype)


def block_attention(q, k, v):
    b, Lq, H, Dh = q.shape
    nb = Lq // Q_BLOCK
    qb = q.reshape(b, nb, Q_BLOCK, N_KV_HEADS, Q_PER_KV, Dh).transpose(1, 0, 2, 3, 4, 5)
    scale = HEAD_DIM ** -0.5

    def one(qblk):
        s = jnp.einsum('bqkgd,bskd->bkgqs', qblk, k, preferred_element_type=F32) * scale
        p = jax.nn.softmax(s, axis=-1)
        o = jnp.einsum('bkgqs,bskd->bqkgd', p.astype(v.dtype), v, preferred_element_type=F32)
        return o.astype(q.dtype)

    o = lax.map(one, qb)
    return o.transpose(1, 0, 2, 3, 4, 5).reshape(b, Lq, H * Dh)


def even_mixer(u, w_in, pool_w_l, pool_scale_l, qk_g, w_out, ctx_kv):
    b, L, _ = u.shape
    p = u @ w_in
    xp, q, k, v = jnp.split(p, [POOL_WIDTH, POOL_WIDTH + ATTN_WIDTH, POOL_WIDTH + ATTN_WIDTH + KV_WIDTH], axis=-1)
    q = rmsnorm(q.reshape(b, L, N_Q_HEADS, HEAD_DIM), qk_g[0])
    k = rmsnorm(k.reshape(b, L, N_KV_HEADS, HEAD_DIM), qk_g[1])
    v = v.reshape(b, L, N_KV_HEADS, HEAD_DIM)
    if ctx_kv is None:
        attn = block_attention(q, k, v)
    else:
        ck, cv = ctx_kv
        k_all = jnp.concatenate([ck.astype(k.dtype), rope_2d(k)], axis=1)
        v_all = jnp.concatenate([cv.astype(v.dtype), v], axis=1)
        attn = block_attention(rope_2d(q), k_all, v_all)
    y = jnp.concatenate([pool_mixer(xp, pool_w_l, pool_scale_l), attn], axis=-1) @ w_out
    return y, k, v


def centred_conv(x, w, bias):
    L = x.shape[1]
    pad = D_CONV // 2
    xpad = jnp.pad(x, ((0, 0), (pad, D_CONV - 1 - pad), (0, 0)))
    out = xpad[:, 0:L] * w[:, 0]
    for j in range(1, D_CONV):
        out = out + xpad[:, j:j + L] * w[:, j]
    return out + bias


def ssd_scan(x, dt, A, Bm, Cm, h0):
    b, L, H, P = x.shape
    nc = L // SSM_CHUNK
    Q = SSM_CHUNK

    def to_chunks(a):
        return jnp.moveaxis(a.reshape(b, nc, Q, *a.shape[2:]), 1, 0)

    xs = to_chunks(x.astype(F32))
    dts = to_chunks(dt)
    Bs = to_chunks(Bm.astype(F32))
    Cs = to_chunks(Cm.astype(F32))
    mask = jnp.tril(jnp.ones((Q, Q), bool))

    def step(h, inp):
        xc, dtc, Bc, Cc = inp
        a = jnp.cumsum(dtc * A, axis=1)
        diff = a[:, :, None, :] - a[:, None, :, :]
        decay = jnp.exp(jnp.where(mask[None, :, :, None], diff, -jnp.inf))
        decay = decay.transpose(0, 3, 1, 2).reshape(b, SSM_GROUPS, HEADS_PER_GROUP, Q, Q)
        cb = jnp.einsum('bign,bjgn->bgij', Cc, Bc)
        wmat = cb[:, :, None] * decay
        xdt = (xc * dtc[..., None]).reshape(b, Q, SSM_GROUPS, HEADS_PER_GROUP, P)
        y_intra = jnp.einsum('bghij,bjghp->bighp', wmat, xdt)
        hg = h.reshape(b, SSM_GROUPS, HEADS_PER_GROUP, P, D_STATE)
        y_state = jnp.einsum('bign,bghpn->bighp', Cc, hg) * jnp.exp(a).reshape(b, Q, SSM_GROUPS, HEADS_PER_GROUP)[..., None]
        dend = jnp.exp(a[:, -1:, :] - a).reshape(b, Q, SSM_GROUPS, HEADS_PER_GROUP)[..., None]
        h_new = h * jnp.exp(a[:, -1])[:, :, None, None] + jnp.einsum('bjgn,bjghp->bghpn', Bc, xdt * dend).reshape(b, H, P, D_STATE)
        return h_new, (y_intra + y_state).reshape(b, Q, H, P)

    hT, ys = lax.scan(step, h0.astype(F32), (xs, dts, Bs, Cs))
    return jnp.moveaxis(ys, 0, 1).reshape(b, L, H, P), hT


def odd_mixer(u, w_in, conv_w, conv_b, dt_bias, A_log, D_skip, norm_g, w_out, h0):
    b, L, _ = u.shape
    z, xbc, dt = jnp.split(u @ w_in, [D_INNER, D_INNER + CONV_DIM], axis=-1)
    xbc = jax.nn.silu(centred_conv(xbc, conv_w, conv_b))
    xs, Bm, Cm = jnp.split(xbc, [D_INNER, D_INNER + SSM_GROUPS * D_STATE], axis=-1)
    xs = xs.reshape(b, L, SSM_HEADS, SSM_HEADDIM)
    Bm = Bm.reshape(b, L, SSM_GROUPS, D_STATE)
    Cm = Cm.reshape(b, L, SSM_GROUPS, D_STATE)
    dt_dir = jax.nn.softplus(dt.astype(F32).reshape(b, L, 2, SSM_HEADS) + dt_bias.astype(F32))
    A = -jnp.exp(A_log.astype(F32))
    Dk = D_skip.astype(F32)
    y_f, h_f = ssd_scan(xs, dt_dir[:, :, 0], A[0], Bm, Cm, h0[:, 0])
    fl = lambda arr: jnp.flip(arr, axis=1)
    y_b, h_b = ssd_scan(fl(xs), fl(dt_dir[:, :, 1]), A[1], fl(Bm), fl(Cm), h0[:, 1])
    x32 = xs.astype(F32)
    y = (y_f + Dk[0][:, None] * x32) + (fl(y_b) + Dk[1][:, None] * x32)
    y = y.reshape(b, L, D_INNER).astype(u.dtype) * jax.nn.silu(z)
    y = rmsnorm(y, norm_g) @ w_out
    return y, jnp.stack([h_f, h_b], axis=1)


def run_trunk(h, cond, ctx_k, ctx_v, ctx_state, ada_w, ada_b, norm_g, ffn_w_in, ffn_w_out,
              mix_w_in, pool_w, pool_scale, qk_norm_g, mix_w_out,
              ssm_w_in, ssm_conv_w, ssm_conv_b, ssm_dt_bias, ssm_A_log, ssm_D, ssm_norm_g, ssm_w_out):
    is_context = ctx_k is None
    ks, vs, ss = [], [], []
    for l in range(DEPTH):
        mods = jnp.split(jax.nn.silu(cond) @ ada_w[l] + ada_b[l], N_MOD, axis=-1)
        g = norm_g[l]
        u = modulate_in(h, g[0], mods[0], mods[1])
        h = residual_add(h, swiglu(u, ffn_w_in[l, 0], ffn_w_out[l, 0]), g[1], mods[2], 0.5)
        u = modulate_in(h, g[2], mods[3], mods[4])
        if l % 2 == 0:
            e = l // 2
            kv = None if is_context else (ctx_k[:, e], ctx_v[:, e])
            y, k, v = even_mixer(u, mix_w_in[e], pool_w[e], pool_scale[e], qk_norm_g[e], mix_w_out[e], kv)
            ks.append(k)
            vs.append(v)
        else:
            o = l // 2
            if is_context:
                h0 = jnp.zeros((h.shape[0], 2, SSM_HEADS, SSM_HEADDIM, D_STATE), F32)
            else:
                h0 = ctx_state[:, o]
            y, hs = odd_mixer(u, ssm_w_in[o], ssm_conv_w[o], ssm_conv_b[o], ssm_dt_bias[o], ssm_A_log[o],
                              ssm_D[o], ssm_norm_g[o], ssm_w_out[o], h0)
            ss.append(hs)
        h = residual_add(h, y, g[3], mods[5], 1.0)
        u = modulate_in(h, g[4], mods[6], mods[7])
        h = residual_add(h, swiglu(u, ffn_w_in[l, 1], ffn_w_out[l, 1]), g[5], mods[8], 0.5)
    return h, ks, vs, ss


def setup_inputs(seed: int = 0) -> dict:
    key = jax.random.key(seed)
    k = jax.random.split(key, 28)
    nrm = lambda kk, shape, s: jax.random.normal(kk, shape, F32) * s
    u_dt = jax.random.uniform(k[25], (N_ODD, 2, SSM_HEADS), F32)
    dt0 = jnp.exp(u_dt * (math.log(0.1) - math.log(0.001)) + math.log(0.001))
    dt_bias = dt0 + jnp.log(-jnp.expm1(-dt0))
    return {
        "x_prompt": nrm(k[0], (BATCH, SEQ, D_MODEL), 1.0),
        "x_sample": nrm(k[1], (DEC_BATCH, DEC_SEQ, D_MODEL), 1.0),
        "cache_k": nrm(k[2], (DEC_BATCH, N_EVEN, PAST_LEN, N_KV_HEADS, HEAD_DIM), 1.0),
        "cache_v": nrm(k[3], (DEC_BATCH, N_EVEN, PAST_LEN, N_KV_HEADS, HEAD_DIM), 1.0),
        "state_ssm": nrm(k[4], (DEC_BATCH, N_ODD, 2, SSM_HEADS, SSM_HEADDIM, D_STATE), 0.1),
        "c": nrm(k[5], (DEC_BATCH, D_MODEL), 1.0),
        "c_ctx": nrm(k[6], (D_MODEL,), 1.0),
        "ada_w": nrm(k[7], (DEPTH, D_MODEL, N_MOD * D_MODEL), 0.5 * D_MODEL ** -0.5),
        "ada_b": nrm(k[8], (DEPTH, N_MOD * D_MODEL), 0.01),
        "norm_g": 1.0 + nrm(k[9], (DEPTH, 6, D_MODEL), 0.05),
        "ffn_w_in": nrm(k[10], (DEPTH, 2, D_MODEL, 2 * D_FF), D_MODEL ** -0.5),
        "ffn_w_out": nrm(k[11], (DEPTH, 2, D_FF, D_MODEL), D_FF ** -0.5),
        "mix_w_in": nrm(k[12], (N_EVEN, D_MODEL, MIX_IN), D_MODEL ** -0.5),
        "pool_w": nrm(k[13], (N_EVEN, N_POOL_GROUPS, POOL_GROUP_DIM, POOL_GROUP_DIM), POOL_GROUP_DIM ** -0.5),
        "pool_scale": 1.0 + nrm(k[14], (N_EVEN, POOL_WIDTH), 0.1),
        "qk_norm_g": 1.0 + nrm(k[15], (N_EVEN, 2, HEAD_DIM), 0.05),
        "mix_w_out": nrm(k[16], (N_EVEN, MIX_OUT, D_MODEL), MIX_OUT ** -0.5),
        "ssm_w_in": nrm(k[17], (N_ODD, D_MODEL, SSM_IN), D_MODEL ** -0.5),
        "ssm_conv_w": nrm(k[18], (N_ODD, CONV_DIM, D_CONV), D_CONV ** -0.5),
        "ssm_conv_b": nrm(k[19], (N_ODD, CONV_DIM), 0.01),
        "ssm_dt_bias": dt_bias,
        "ssm_A_log": jnp.log(jax.random.uniform(k[20], (N_ODD, 2, SSM_HEADS), F32, 1.0, 16.0)),
        "ssm_D": 1.0 + nrm(k[21], (N_ODD, 2, SSM_HEADS), 0.1),
        "ssm_norm_g": 1.0 + nrm(k[22], (N_ODD, D_INNER), 0.05),
        "ssm_w_out": nrm(k[23], (N_ODD, D_INNER, D_MODEL), D_INNER ** -0.5),
    }


def reference(x_prompt, x_sample, cache_k, cache_v, state_ssm, c, c_ctx,
              ada_w, ada_b, norm_g, ffn_w_in, ffn_w_out,
              mix_w_in, pool_w, pool_scale, qk_norm_g, mix_w_out,
              ssm_w_in, ssm_conv_w, ssm_conv_b, ssm_dt_bias, ssm_A_log, ssm_D, ssm_norm_g, ssm_w_out):
    y_prompt, ks, vs, ss = run_trunk(
        x_prompt, c_ctx[None], None, None, None, ada_w, ada_b, norm_g, ffn_w_in, ffn_w_out,
        mix_w_in, pool_w, pool_scale, qk_norm_g, mix_w_out,
        ssm_w_in, ssm_conv_w, ssm_conv_b, ssm_dt_bias, ssm_A_log, ssm_D, ssm_norm_g, ssm_w_out)
    new_k = jnp.stack(ks, axis=1)
    new_v = jnp.stack(vs, axis=1)
    new_ssm = jnp.stack(ss, axis=1)
    y_sample, _, _, _ = run_trunk(
        x_sample, c, cache_k, cache_v, state_ssm, ada_w, ada_b, norm_g, ffn_w_in, ffn_w_out,
        mix_w_in, pool_w, pool_scale, qk_norm_g, mix_w_out,
        ssm_w_in, ssm_conv_w, ssm_conv_b, ssm_dt_bias, ssm_A_log, ssm_D, ssm_norm_g, ssm_w_out)
    return (y_prompt, y_sample, new_k, new_v, new_ssm)
```

```cpp
#include <hip/hip_runtime.h>
#include <cstdio>
#include <cstdint>

#ifndef MK_ONE_LAUNCH
#define MK_ONE_LAUNCH 1
#endif

constexpr int DM = 2048, NP_TOK = 4096, NS_TOK = 8192, MTOK = 12288, DFF = 5632, NMODS = 9 * DM;
constexpr int MIXIN = 2560, DINNER = 4096, CONVD = 6144, SSMIN_PAD = 10496, ZXB_LD = 10240;
constexpr float EPS = 1e-6f;
constexpr int OUT_YP = 0, OUT_K = 25165824, OUT_V = 26214400, OUT_SSM = 27262976, OUT_TOTAL = 44040192;

constexpr size_t MiB = 1u << 20;
constexpr size_t WS_CTL = 0, CTL_ZERO_BYTES = 1 * MiB;
constexpr size_t WS_MODS = 1 * MiB;
constexpr size_t WS_ROPE = 2 * MiB + 512 * 1024;
constexpr size_t WS_W1T = 3 * MiB;
constexpr size_t WS_W2T = WS_W1T + 176 * MiB;
constexpr size_t WS_WMI = WS_W2T + 88 * MiB;
constexpr size_t WS_WMO = WS_WMI + 10 * MiB;
constexpr size_t WS_WSI = WS_WMO + 8 * MiB;
constexpr size_t WS_WSO = WS_WSI + 41 * MiB;
constexpr size_t WS_WPL = WS_WSO + 16 * MiB;
constexpr size_t WS_H = WS_WPL + 1 * MiB;
constexpr size_t WS_U = WS_H + 96 * MiB;
constexpr size_t WS_HID = WS_U + 48 * MiB;
constexpr size_t WS_Y = WS_HID + 132 * MiB;
constexpr size_t WS_MS = WS_Y + 96 * MiB;
constexpr size_t WS_P = WS_MS;
constexpr size_t WS_Q = WS_P + 120 * MiB;
constexpr size_t WS_KP = WS_Q + 24 * MiB;
constexpr size_t WS_VP = WS_KP + 2 * MiB;
constexpr size_t WS_KS = WS_VP + 2 * MiB;
constexpr size_t WS_VS = WS_KS + 6 * MiB;
constexpr size_t WS_D = WS_VS + 6 * MiB;
constexpr size_t WS_CAT = WS_D + 24 * MiB;
constexpr size_t WS_ZXB = WS_MS;
constexpr size_t WS_DT = WS_ZXB + 240 * MiB;
constexpr size_t WS_DTS = WS_DT + 6 * MiB;
constexpr size_t WS_XBC = WS_DTS + 6 * MiB;
constexpr size_t WS_YF = WS_XBC + 144 * MiB;
constexpr size_t WS_YB = WS_YF + 96 * MiB;
constexpr size_t WS_END = WS_YB + 96 * MiB;
static_assert(WS_CAT + 48 * MiB <= WS_END, "ws map");

constexpr int CW_BAR = 4096;

#define LAS __attribute__((address_space(3)))
#define GAS __attribute__((address_space(1)))
typedef unsigned short bf16_t;
typedef short bf16x8 __attribute__((ext_vector_type(8)));
typedef float f32x4 __attribute__((ext_vector_type(4)));
typedef unsigned u32x4 __attribute__((ext_vector_type(4)));
typedef unsigned u32x2 __attribute__((ext_vector_type(2)));

template <class T> __device__ __forceinline__ T ldg(const void* p) { return *(const GAS T*)p; }
template <class T> __device__ __forceinline__ void stg(void* p, T v) { *(GAS T*)p = v; }
typedef float f32x2n __attribute__((ext_vector_type(2)));
typedef __bf16 bf16x2n __attribute__((ext_vector_type(2)));
__device__ __forceinline__ unsigned pkbf(float lo, float hi) { return __builtin_bit_cast(unsigned, __builtin_convertvector((f32x2n){lo, hi}, bf16x2n)); }
__device__ __forceinline__ unsigned f2bf(float f) { return (unsigned)__builtin_bit_cast(unsigned short, (__bf16)f); }
__device__ __forceinline__ unsigned pk2(float lo, float hi) { return pkbf(lo, hi); }
__device__ __forceinline__ float bf2f(unsigned b) { return __builtin_bit_cast(float, b << 16); }
__device__ __forceinline__ float bflo(unsigned w) { return __builtin_bit_cast(float, w << 16); }
__device__ __forceinline__ float bfhi(unsigned w) { return __builtin_bit_cast(float, w & 0xffff0000u); }
__device__ __forceinline__ float lane_xor(float v, int lane, int o) { return __builtin_bit_cast(float, __builtin_amdgcn_ds_bpermute((lane ^ o) << 2, __builtin_bit_cast(int, v))); }
__device__ __forceinline__ float wave_sum(float v, int lane) {
#pragma unroll
    for (int o = 1; o < 64; o <<= 1) v += lane_xor(v, lane, o);
    return v;
}
__device__ __forceinline__ float silu_f(float x) { return x * __builtin_amdgcn_rcpf(1.0f + __expf(-x)); }

#define XB_TMO      128
#define XB_XCNT(j)  (256  + 64 * (j))
#define XB_XSUB(j)  (1280 + 64 * (j))
#define XB_XGEN(j)  (2304 + 64 * (j))
#define XB_TOP      3328
#define XB_TOPGEN   3392
#define XCD_BAR_WORDS 3456
#define XB_SPIN_CAP (1u << 18)
__device__ __forceinline__ unsigned xb_ld(unsigned* p)              { return __hip_atomic_load(p, __ATOMIC_RELAXED, __HIP_MEMORY_SCOPE_AGENT); }
__device__ __forceinline__ unsigned xb_add(unsigned* p, unsigned v) { return __hip_atomic_fetch_add(p, v, __ATOMIC_RELAXED, __HIP_MEMORY_SCOPE_AGENT); }
__device__ __forceinline__ unsigned xb_xcc_id() { return (unsigned)__builtin_amdgcn_s_getreg((3 << 11) | 20) & 0xFu; }
#define XB_SPIN(cond, bar) do { unsigned _sp = 0; while (cond) { __builtin_amdgcn_s_sleep(1); \
    if ((++_sp & 255u) == 0u) { if (xb_ld(&(bar)[XB_TMO])) break; if (_sp > XB_SPIN_CAP) { atomicAdd(&(bar)[XB_TMO], 1u); break; } } } } while (0)
struct XcdBarrier { unsigned* bar; unsigned x; volatile LAS unsigned* st; };
__device__ __forceinline__ XcdBarrier xcd_barrier_post(unsigned* bar, volatile LAS unsigned* st) {
    XcdBarrier b; b.bar = bar; b.x = xb_xcc_id(); b.st = st;
    if (threadIdx.x == 0) (void)xb_add(&bar[XB_XCNT(b.x)], 1u);
    return b;
}
__device__ __forceinline__ void xcd_barrier_complete(unsigned* bar, unsigned x, unsigned& nloc, unsigned& nx) {
    const unsigned G = gridDim.x * gridDim.y * gridDim.z;
    unsigned sum, cnt, mine, sp = 0u;
    for (;;) {
        sum = 0u; cnt = 0u; mine = 0u;
#pragma unroll
        for (unsigned j = 0; j < 16; ++j) { const unsigned c = xb_ld(&bar[XB_XCNT(j)]); sum += c; cnt += (c > 0u) ? 1u : 0u; mine = (j == x) ? c : mine; }
        if (sum == G) break;
        __builtin_amdgcn_s_sleep(1);
        if ((++sp & 255u) == 0u) { if (xb_ld(&bar[XB_TMO])) break; if (sp > XB_SPIN_CAP) { atomicAdd(&bar[XB_TMO], 1u); break; } }
    }
    nloc = mine > 0u ? mine : 1u; nx = cnt > 0u ? cnt : 1u;
}
__device__ __forceinline__ void xcd_barrier(const XcdBarrier& b, const bool leader) {
    asm volatile("s_waitcnt vmcnt(0)" ::: "memory");
    __syncthreads();
    if (leader) {
        unsigned* bar = b.bar; asm volatile("" : "+s"(bar));
        __builtin_amdgcn_s_waitcnt(0);
        unsigned nloc = b.st[0], nx = b.st[1];
        unsigned bx = b.x; asm volatile("" : "+s"(bx));
        if (nloc == 0u) { xcd_barrier_complete(bar, bx, nloc, nx); b.st[0] = nloc; b.st[1] = nx; }
        const unsigned old = xb_add(&bar[XB_XSUB(bx)], 1u);
        const unsigned gen = old / nloc;
        if (old + 1u == (gen + 1u) * nloc) {
            __builtin_amdgcn_fence(__ATOMIC_RELEASE, "agent");
            asm volatile("s_waitcnt vmcnt(0)" ::: "memory");
            const unsigned og = xb_add(&bar[XB_TOP], 1u);
            const unsigned tg = og / nx;
            if (og + 1u == (tg + 1u) * nx) xb_add(&bar[XB_TOPGEN], 1u);
            else XB_SPIN(xb_ld(&bar[XB_TOPGEN]) == tg, bar);
            __builtin_amdgcn_fence(__ATOMIC_ACQUIRE, "agent");
            xb_add(&bar[XB_XGEN(bx)], 1u);
            asm volatile("s_waitcnt vmcnt(0)" ::: "memory");
        } else {
            XB_SPIN(xb_ld(&bar[XB_XGEN(bx)]) == gen, bar);
            __builtin_amdgcn_fence(__ATOMIC_ACQUIRE, "agent");
            asm volatile("s_waitcnt vmcnt(0)" ::: "memory");
        }
    }
    __syncthreads();
}

namespace pg8 {
constexpr int BM = 256, BK = 64, HALF = 128, HTB = HALF * BK * 2, STAGE_BYTES = 8 * HTB, NXCD = 8, WGM = 8;
__host__ __device__ __forceinline__ int lds_byte(int r, int c) { const int st = (r >> 4) * 2 + (c >> 5), rr = r & 15, cc = c & 31, ob = rr * 64 + cc * 2; return st * 1024 + (ob ^ (((ob >> 9) & 1) << 5)); }
__host__ __device__ __forceinline__ void stage_rc(int b, int& R, int& C) { const int st = b / 1024, sb = b % 1024, swz = sb ^ (((sb >> 9) & 1) << 5); R = (st >> 1) * 16 + swz / 64; C = (st & 1) * 32 + (swz % 64) / 2; }
__host__ __device__ __forceinline__ int perm32(int rho) { const int n = rho >> 4, i = rho & 15; return 8 * (i >> 2) + 4 * n + (i & 3); }
struct Unit { int pm, pn, full; };
struct Gemm { const bf16_t* A; const bf16_t* Bt; int M, N, K, lda, ldb; size_t a_pn_step; int nNr; size_t ksb; };
struct StaticOrder {
    int nM, nN, nwg, G, c, rev;
    __host__ __device__ void init(int M, int N, int G_, int c_, int rev_ = 0) { nM = M / BM; nN = N / BM; nwg = nM * nN; G = G_; c = c_; rev = rev_; }
    __host__ __device__ bool at(long L, Unit& u) const {
        if (L >= nwg) return false;
        int wgid = (int)L; { const int q = nwg / NXCD, r = nwg % NXCD, xcd = wgid % NXCD, off = wgid / NXCD; wgid = (xcd < r ? xcd * (q + 1) : r * (q + 1) + (xcd - r) * q) + off; }
        const int nig = WGM * nN, gid0 = wgid / nig, gid = rev ? (nM + WGM - 1) / WGM - 1 - gid0 : gid0, fm = gid * WGM, gsz = (nM - fm) < WGM ? (nM - fm) : WGM;
        u.pm = fm + ((wgid % nig) % gsz); u.pn = (wgid % nig) / gsz; u.full = 0; return true;
    }
    __host__ __device__ bool next(int i, Unit& u) const { return at((long)i * G + c, u); }
};
struct MixedOrder {
    StaticOrder a, b; int G, c;
    __host__ __device__ void init(int G_, int c_) { a.init(8192, 2048, G_, c_); b.init(4096, 4096, G_, c_); G = G_; c = c_; }
    __host__ __device__ bool next(int i, Unit& u) const {
        const long L = (long)i * G + c;
        if (L < 256) { const bool r = a.at(L, u); u.full = 1; return r; }
        const bool r = b.at(L - 256, u); u.pm += 32; return r;
    }
};
__device__ __forceinline__ unsigned cvt_pk_bf16(float lo, float hi) { return pkbf(lo, hi); }

struct EpiF32 {
    static constexpr bool PERM = false;
    float* C; int ldc;
    __device__ __forceinline__ void operator()(const f32x4 (&acc)[2][2][4][2], const Unit& u, int wr, int wc, int fr, int fq) const {
        const int row0 = u.pm * BM + wr * 64 + fr, col0 = u.pn * BM + wc * 32 + 4 * fq;
#pragma unroll
        for (int ai = 0; ai < 2; ++ai)
#pragma unroll
            for (int m = 0; m < 4; ++m) { float* rowp = C + (size_t)(row0 + ai * HALF + m * 16) * ldc + col0;
#pragma unroll
                for (int bj = 0; bj < 2; ++bj)
#pragma unroll
                    for (int n = 0; n < 2; ++n) stg<f32x4>(rowp + bj * HALF + n * 16, acc[ai][bj][m][n]); }
    }
};
struct EpiSwiGLU {
    static constexpr bool PERM = true;
    bf16_t* O; int ldc;
    __device__ __forceinline__ void operator()(const f32x4 (&acc)[2][2][4][2], const Unit& u, int wr, int wc, int fr, int fq) const {
        const int row0 = u.pm * BM + wr * 64 + fr, col0 = u.pn * HALF + wc * 32 + 8 * fq;
#pragma unroll
        for (int ai = 0; ai < 2; ++ai)
#pragma unroll
            for (int m = 0; m < 4; ++m) { bf16_t* rowp = O + (size_t)(row0 + ai * HALF + m * 16) * ldc + col0;
                float v[8];
#pragma unroll
                for (int n = 0; n < 2; ++n)
#pragma unroll
                    for (int i = 0; i < 4; ++i) { const float a = acc[ai][0][m][n][i], b = acc[ai][1][m][n][i]; v[n * 4 + i] = a * __builtin_amdgcn_rcpf(1.0f + __expf(-a)) * b; }
                u32x4 w; w.x = cvt_pk_bf16(v[0], v[1]); w.y = cvt_pk_bf16(v[2], v[3]); w.z = cvt_pk_bf16(v[4], v[5]); w.w = cvt_pk_bf16(v[6], v[7]);
                stg<u32x4>(rowp, w); }
    }
};
struct EpiBf16S {
    static constexpr bool PERM = true;
    bf16_t* O; int ldc; const float* scale;
    __device__ __forceinline__ void operator()(const f32x4 (&acc)[2][2][4][2], const Unit& u, int wr, int wc, int fr, int fq) const {
        const int row0 = u.pm * BM + wr * 64 + fr, col0 = u.pn * BM + wc * 32 + 8 * fq;
        f32x4 sv[2][2];
#pragma unroll
        for (int bj = 0; bj < 2; ++bj)
#pragma unroll
            for (int n = 0; n < 2; ++n) sv[bj][n] = scale ? ldg<f32x4>(scale + col0 + bj * HALF + 4 * n) : (f32x4){1.f, 1.f, 1.f, 1.f};
#pragma unroll
        for (int ai = 0; ai < 2; ++ai)
#pragma unroll
            for (int m = 0; m < 4; ++m) { bf16_t* rowp = O + (size_t)(row0 + ai * HALF + m * 16) * ldc + col0;
#pragma unroll
                for (int bj = 0; bj < 2; ++bj) { const f32x4 v0 = acc[ai][bj][m][0] * sv[bj][0], v1 = acc[ai][bj][m][1] * sv[bj][1];
                    u32x4 w; w.x = cvt_pk_bf16(v0[0], v0[1]); w.y = cvt_pk_bf16(v0[2], v0[3]); w.z = cvt_pk_bf16(v1[0], v1[1]); w.w = cvt_pk_bf16(v1[2], v1[3]);
                    stg<u32x4>(rowp + bj * HALF, w); } }
    }
};
struct EpiBf16Part {
    static constexpr bool PERM = true;
    bf16_t* O; int ldc; size_t plane; int nNr;
    __device__ __forceinline__ void operator()(const f32x4 (&acc)[2][2][4][2], const Unit& u, int wr, int wc, int fr, int fq) const {
        const int kh = u.pn / nNr, pnr = u.pn - kh * nNr;
        const int row0 = u.pm * BM + wr * 64 + fr, col0 = pnr * BM + wc * 32 + 8 * fq; bf16_t* base = O + (size_t)kh * plane;
#pragma unroll
        for (int ai = 0; ai < 2; ++ai)
#pragma unroll
            for (int m = 0; m < 4; ++m) { bf16_t* rowp = base + (size_t)(row0 + ai * HALF + m * 16) * ldc + col0;
#pragma unroll
                for (int bj = 0; bj < 2; ++bj) { const f32x4 v0 = acc[ai][bj][m][0], v1 = acc[ai][bj][m][1];
                    u32x4 w; w.x = cvt_pk_bf16(v0[0], v0[1]); w.y = cvt_pk_bf16(v0[2], v0[3]); w.z = cvt_pk_bf16(v1[0], v1[1]); w.w = cvt_pk_bf16(v1[2], v1[3]);
                    stg<u32x4>(rowp + bj * HALF, w); } }
    }
};
struct EpiSsmIn {
    static constexpr bool PERM = true;
    bf16_t* Z; float* DT;
    __device__ __forceinline__ void operator()(const f32x4 (&acc)[2][2][4][2], const Unit& u, int wr, int wc, int fr, int fq) const {
        const int row0 = u.pm * BM + wr * 64 + fr;
        if (u.pn < 40) {
            const int col0 = u.pn * BM + wc * 32 + 8 * fq;
#pragma unroll
            for (int ai = 0; ai < 2; ++ai)
#pragma unroll
                for (int m = 0; m < 4; ++m) { bf16_t* rowp = Z + (size_t)(row0 + ai * HALF + m * 16) * ZXB_LD + col0;
#pragma unroll
                    for (int bj = 0; bj < 2; ++bj) { const f32x4 v0 = acc[ai][bj][m][0], v1 = acc[ai][bj][m][1];
                        u32x4 w; w.x = cvt_pk_bf16(v0[0], v0[1]); w.y = cvt_pk_bf16(v0[2], v0[3]); w.z = cvt_pk_bf16(v1[0], v1[1]); w.w = cvt_pk_bf16(v1[2], v1[3]);
                        stg<u32x4>(rowp + bj * HALF, w); } }
        } else {
            const int col0 = wc * 32 + 8 * fq;
#pragma unroll
            for (int ai = 0; ai < 2; ++ai)
#pragma unroll
                for (int m = 0; m < 4; ++m) { float* rowp = DT + (size_t)(row0 + ai * HALF + m * 16) * 128 + col0;
                    stg<f32x4>(rowp, acc[ai][0][m][0]); stg<f32x4>(rowp + 4, acc[ai][0][m][1]); }
        }
    }
};

template <class Epi, class Sched>
__device__ __forceinline__ void gemm_phase(LAS unsigned char* lds, const Gemm g, const Sched& S, const Epi& E, const int tid) {
    const int wid = __builtin_amdgcn_readfirstlane(tid >> 6), lane = tid & 63, wr = wid >> 2, wc = wid & 3, fr = lane & 15, fq = lane >> 4;
    const int ntb = g.K / BK;
    unsigned voffA[2], voffB[2];
#pragma unroll
    for (int i = 0; i < 2; ++i) { int R, C; stage_rc(tid * 16 + i * 8192, R, C); const int Rb = Epi::PERM ? ((R & ~31) + perm32(R & 31)) : R;
        voffA[i] = (unsigned)(R * g.lda + C) * 2u; voffB[i] = (unsigned)(Rb * g.ldb + C) * 2u; }
    const size_t kstep = (size_t)(BK * 2);
    const size_t hstepA = (size_t)HALF * g.lda * 2, hstepB = (size_t)HALF * g.ldb * 2;
    const size_t tstepA = 2 * hstepA, tstepB = 2 * hstepB;
    const unsigned ldsw = (unsigned)wid * 1024u;
    const int aoff = lds_byte(wr * 64 + fr, fq * 8), boff = lds_byte(wc * 32 + fr, fq * 8);
#define PG8_SA(b, h) (((b) * 2 + (h)) * HTB)
#define PG8_SB(b, h) ((4 + (b) * 2 + (h)) * HTB)
#define PG8_STAGE(bufoff, gbase, voff) do { _Pragma("unroll") for (int _i = 0; _i < 2; ++_i) \
        __builtin_amdgcn_global_load_lds((const unsigned*)((const char*)(gbase) + (voff)[_i]), (LAS unsigned*)(lds + (bufoff) + ldsw + _i * 8192), 16, 0, 0); } while (0)
#define PG8_LDA(dst, b, h) do { _Pragma("unroll") for (int m = 0; m < 4; ++m) _Pragma("unroll") for (int k = 0; k < 2; ++k) dst[m][k] = *(const LAS bf16x8*)(lds + PG8_SA(b, h) + aoff + m * 2048 + k * 1024); } while (0)
#define PG8_LDB(dst, b, h) do { _Pragma("unroll") for (int n = 0; n < 2; ++n) _Pragma("unroll") for (int k = 0; k < 2; ++k) dst[n][k] = *(const LAS bf16x8*)(lds + PG8_SB(b, h) + boff + n * 2048 + k * 1024); } while (0)
#define PG8_MMA(ai, bj, At, Bt) do { __builtin_amdgcn_s_setprio(1); _Pragma("unroll") for (int m = 0; m < 4; ++m) _Pragma("unroll") for (int n = 0; n < 2; ++n) _Pragma("unroll") for (int k = 0; k < 2; ++k) \
        acc[ai][bj][m][n] = __builtin_amdgcn_mfma_f32_16x16x32_bf16(Bt[n][k], At[m][k], acc[ai][bj][m][n], 0, 0, 0); __builtin_amdgcn_s_setprio(0); } while (0)
#define PG8_WAIT_V(n) asm volatile("s_waitcnt vmcnt(" #n ")" ::: "memory")
#define PG8_WAIT_L(n) asm volatile("s_waitcnt lgkmcnt(" #n ")" ::: "memory")
#define PG8_BAR __builtin_amdgcn_s_barrier()
#define PG8_SCHED __builtin_amdgcn_sched_barrier(0)
    Unit cur, nxt; int ui = 0;
    if (!S.next(0, cur)) return;
    f32x4 acc[2][2][4][2];
#pragma unroll
    for (int a = 0; a < 2; ++a)
#pragma unroll
        for (int b = 0; b < 2; ++b)
#pragma unroll
            for (int m = 0; m < 4; ++m)
#pragma unroll
                for (int n = 0; n < 2; ++n) acc[a][b][m][n] = (f32x4){0.f, 0.f, 0.f, 0.f};
    bf16x8 At[4][2], B0[2][2], B1[2][2];
    const char* cA; const char* cB;
    { const int kh = cur.pn / g.nNr, pnr = cur.pn - kh * g.nNr;
      cA = (const char*)g.A + (size_t)cur.pm * tstepA + (size_t)pnr * g.a_pn_step + (size_t)kh * g.ksb; cB = (const char*)g.Bt + (size_t)pnr * tstepB + (size_t)kh * g.ksb; }
    PG8_STAGE(PG8_SB(0, 0), cB, voffB); PG8_STAGE(PG8_SB(0, 1), cB + hstepB, voffB); PG8_STAGE(PG8_SA(0, 0), cA, voffA); PG8_STAGE(PG8_SA(0, 1), cA + hstepA, voffA);
    if (wr == 1) PG8_BAR;
    PG8_WAIT_V(2); PG8_BAR;
    PG8_STAGE(PG8_SB(1, 0), cB + kstep, voffB); PG8_STAGE(PG8_SA(1, 0), cA + kstep, voffA); PG8_STAGE(PG8_SB(1, 1), cB + hstepB + kstep, voffB);
    PG8_WAIT_V(6); PG8_BAR;
    for (;;) {
        const bool has_next = S.next(ui + 1, nxt);
        const int nt = cur.full ? 2 * ntb : ntb;
        const char* nA = cA; const char* nB = cB;
        if (has_next) { const int kh = nxt.pn / g.nNr, pnr = nxt.pn - kh * g.nNr;
            nA = (const char*)g.A + (size_t)nxt.pm * tstepA + (size_t)pnr * g.a_pn_step + (size_t)kh * g.ksb; nB = (const char*)g.Bt + (size_t)pnr * tstepB + (size_t)kh * g.ksb; }
        for (int t = 0; t < nt; t += 2) {
            const bool last = (t == nt - 2);
            const char* a1 = cA + (size_t)(t + 1) * kstep;
            const char* a2 = last ? nA : cA + (size_t)(t + 2) * kstep; const char* b2 = last ? nB : cB + (size_t)(t + 2) * kstep;
            const char* a3 = a2 + kstep; const char* b3 = b2 + kstep;
            PG8_LDB(B0, 0, 0); PG8_LDB(B1, 0, 1); PG8_SCHED; PG8_LDA(At, 0, 0); PG8_STAGE(PG8_SA(1, 1), a1 + hstepA, voffA);
            PG8_WAIT_V(8); PG8_WAIT_L(0); PG8_BAR; PG8_MMA(0, 0, At, B0); PG8_MMA(0, 1, At, B1); PG8_BAR; PG8_SCHED;
            PG8_LDA(At, 0, 1); PG8_STAGE(PG8_SB(0, 0), b2, voffB); PG8_STAGE(PG8_SB(0, 1), b2 + hstepB, voffB); PG8_STAGE(PG8_SA(0, 0), a2, voffA);
            PG8_WAIT_V(8); PG8_WAIT_L(0); PG8_BAR; PG8_MMA(1, 0, At, B0); PG8_MMA(1, 1, At, B1); PG8_BAR; PG8_SCHED;
            PG8_LDB(B0, 1, 0); PG8_LDB(B1, 1, 1); PG8_SCHED; PG8_LDA(At, 1, 0); PG8_STAGE(PG8_SA(0, 1), a2 + hstepA, voffA);
            PG8_WAIT_V(8); PG8_WAIT_L(0); PG8_BAR; PG8_MMA(0, 0, At, B0); PG8_MMA(0, 1, At, B1); PG8_BAR; PG8_SCHED;
            PG8_LDA(At, 1, 1); PG8_STAGE(PG8_SB(1, 0), b3, voffB); PG8_STAGE(PG8_SB(1, 1), b3 + hstepB, voffB); PG8_STAGE(PG8_SA(1, 0), a3, voffA);
            PG8_WAIT_V(8); PG8_WAIT_L(0); PG8_BAR; PG8_MMA(1, 0, At, B0); PG8_MMA(1, 1, At, B1); PG8_BAR; PG8_SCHED;
        }
        if (wr == 0) PG8_BAR;
        E(acc, cur, wr, wc, fr, fq);
        if (!has_next) break;
#pragma unroll
        for (int a = 0; a < 2; ++a)
#pragma unroll
            for (int b = 0; b < 2; ++b)
#pragma unroll
                for (int m = 0; m < 4; ++m)
#pragma unroll
                    for (int n = 0; n < 2; ++n) acc[a][b][m][n] = (f32x4){0.f, 0.f, 0.f, 0.f};
        cur = nxt; cA = nA; cB = nB; ++ui;
        if (wr == 1) PG8_BAR;
    }
    PG8_WAIT_V(0);
    PG8_BAR;
#undef PG8_SA
#undef PG8_SB
#undef PG8_STAGE
#undef PG8_LDA
#undef PG8_LDB
#undef PG8_MMA
#undef PG8_WAIT_V
#undef PG8_WAIT_L
#undef PG8_BAR
#undef PG8_SCHED
}
}

namespace att {
constexpr int D = 128, NW = 8, QBLK = 32, KVBLK = 64;
constexpr float SCALE = 0.088388347648318440f;
constexpr float THR = 8.f;
constexpr size_t SHM_V = KVBLK * D * 2, SHM_K = KVBLK * D * 2, SHM_ATTN = 2 * SHM_V + 2 * SHM_K + NW * 64 * 4;
using s16x4  = __attribute__((ext_vector_type(4))) short;
using f32x16 = __attribute__((ext_vector_type(16))) float;
#define KSWZ(row, colB) ((row) * 256 + ((colB) ^ (((row) & 7) << 4)))
#define SBAR() __builtin_amdgcn_sched_barrier(0)
__device__ __forceinline__ int crow(int r, int hi) { return (r & 3) + 8 * (r >> 2) + 4 * hi; }
__device__ __forceinline__ unsigned cvtpk(float lo, float hi) { return pkbf(lo, hi); }
__device__ __forceinline__ void partialSM(f32x16& p0, f32x16& p1, float& m_reg, float& mn, float& alpha) {
  constexpr float C = SCALE * 1.4426950408889634f;
  float pmax = p0[0]; for (int r = 1; r < 16; ++r) pmax = fmaxf(pmax, p0[r]); for (int r = 0; r < 16; ++r) pmax = fmaxf(pmax, p1[r]);
  { auto rr = __builtin_amdgcn_permlane32_swap(__float_as_uint(pmax), __float_as_uint(pmax), false, false);
    pmax = fmaxf(__uint_as_float(rr[0]), __uint_as_float(rr[1])); }
  if (__builtin_expect(__all(pmax - m_reg <= THR / SCALE), 1)) { mn = m_reg; alpha = 1.f; }
  else { mn = fmaxf(m_reg, pmax); alpha = __builtin_amdgcn_exp2f((m_reg - mn) * C); m_reg = mn; }
  float mnC = -mn * C;
  for (int r = 0; r < 16; ++r) p0[r] = fmaf(p0[r], C, mnC); for (int r = 0; r < 16; ++r) p1[r] = fmaf(p1[r], C, mnC);
  for (int r = 0; r < 16; ++r) p0[r] = __builtin_amdgcn_exp2f(p0[r]);
}
__device__ __forceinline__ void finishSM(f32x16& p0, f32x16& p1, float alpha, float& l_reg, bf16x8& pa0, bf16x8& pa1, bf16x8& pa2, bf16x8& pa3) {
  for (int r = 0; r < 16; ++r) p1[r] = __builtin_amdgcn_exp2f(p1[r]);
  float ps = 0; for (int r = 0; r < 16; ++r) ps += p0[r]; for (int r = 0; r < 16; ++r) ps += p1[r];
  { auto rr = __builtin_amdgcn_permlane32_swap(__float_as_uint(ps), __float_as_uint(ps), false, false);
    ps = __uint_as_float(rr[0]) + __uint_as_float(rr[1]); }
  l_reg = l_reg * alpha + ps;
#define PK4(P, BASE, OUT) do { unsigned a0 = cvtpk(P[BASE + 0], P[BASE + 1]), a1 = cvtpk(P[BASE + 2], P[BASE + 3]);   \
    unsigned b0 = cvtpk(P[BASE + 4], P[BASE + 5]), b1 = cvtpk(P[BASE + 6], P[BASE + 7]);                              \
    auto r0 = __builtin_amdgcn_permlane32_swap(a0, b0, false, false); auto r1 = __builtin_amdgcn_permlane32_swap(a1, b1, false, false); \
    u32x4 w = {r0[0], r1[0], r0[1], r1[1]}; OUT = *reinterpret_cast<bf16x8*>(&w); } while (0)
  PK4(p0, 0, pa0); PK4(p0, 8, pa1); PK4(p1, 0, pa2); PK4(p1, 8, pa3);
#undef PK4
}
__device__ __forceinline__ void qkt(f32x16& p0, f32x16& p1, const LAS char* Ks, const bf16x8* qr, int r32, int hi) {
  p0 = f32x16{}; p1 = f32x16{};
  for (int d0 = 0; d0 < 8; ++d0) { int cb = (d0 * 16 + hi * 8) * 2;
    bf16x8 b0 = *(const LAS bf16x8*)(Ks + KSWZ(r32, cb));
    bf16x8 b1 = *(const LAS bf16x8*)(Ks + KSWZ(32 + r32, cb));
    p0 = __builtin_amdgcn_mfma_f32_32x32x16_bf16(b0, qr[d0], p0, 0, 0, 0);
    p1 = __builtin_amdgcn_mfma_f32_32x32x16_bf16(b1, qr[d0], p1, 0, 0, 0); }
}
__device__ __forceinline__ int v_st(int k, int c) { const int kk = (k & ~0xC) | ((k & 4) << 1) | ((k & 8) >> 1); return ((kk >> 3) * 4 + (c >> 5)) * 512 + ((kk & 7) * 32 + (c & 31)) * 2; }
__device__ __forceinline__ int v_rd_base(int lane) { return ((lane & 3) << 3) | (((lane >> 2) & 3) << 6) | (((lane >> 4) & 1) << 5) | (((lane >> 5) & 1) << 8); }
constexpr int v_rd_off(int d0, int ks, int half) { return d0 * 512 + ks * 4096 + half * 2048; }
template <int OFF> __device__ __forceinline__ s16x4 tr_read(int vb) {
  s16x4 r; asm volatile("ds_read_b64_tr_b16 %0, %1 offset:%2" : "=&v"(r) : "v"(vb), "i"(OFF) : "memory"); return r;
}
template <int D0> __device__ __forceinline__ void pv_one(f32x16& od, int vb, bf16x8 pa0, bf16x8 pa1, bf16x8 pa2, bf16x8 pa3) {
  const s16x4 l0 = tr_read<v_rd_off(D0, 0, 0)>(vb), h0 = tr_read<v_rd_off(D0, 0, 1)>(vb), l1 = tr_read<v_rd_off(D0, 1, 0)>(vb), h1 = tr_read<v_rd_off(D0, 1, 1)>(vb);
  const s16x4 l2 = tr_read<v_rd_off(D0, 2, 0)>(vb), h2 = tr_read<v_rd_off(D0, 2, 1)>(vb), l3 = tr_read<v_rd_off(D0, 3, 0)>(vb), h3 = tr_read<v_rd_off(D0, 3, 1)>(vb);
  asm volatile("s_waitcnt lgkmcnt(0)" ::: "memory"); SBAR();
#define PK(L, H) (bf16x8){L[0], L[1], L[2], L[3], H[0], H[1], H[2], H[3]}
  od = __builtin_amdgcn_mfma_f32_32x32x16_bf16(pa0, PK(l0, h0), od, 0, 0, 0);
  od = __builtin_amdgcn_mfma_f32_32x32x16_bf16(pa1, PK(l1, h1), od, 0, 0, 0);
  od = __builtin_amdgcn_mfma_f32_32x32x16_bf16(pa2, PK(l2, h2), od, 0, 0, 0);
  od = __builtin_amdgcn_mfma_f32_32x32x16_bf16(pa3, PK(l3, h3), od, 0, 0, 0);
#undef PK
}
__device__ __forceinline__ void pv_d0(f32x16* o, int vb, bf16x8 pa0, bf16x8 pa1, bf16x8 pa2, bf16x8 pa3) {
  pv_one<0>(o[0], vb, pa0, pa1, pa2, pa3); pv_one<1>(o[1], vb, pa0, pa1, pa2, pa3); pv_one<2>(o[2], vb, pa0, pa1, pa2, pa3); pv_one<3>(o[3], vb, pa0, pa1, pa2, pa3);
}
template <int LDQ, int LDK, int LDO>
__device__ __forceinline__ void attn_body(const bf16_t* __restrict__ Qb, const bf16_t* __restrict__ Kh, const bf16_t* __restrict__ Vh, bf16_t* __restrict__ Ob, int seq, LAS char* lds, const int tid) {
  const int wid = tid >> 6, lane = tid & 63, r32 = lane & 31, hi = lane >> 5;
  LAS char* V_lds = lds; LAS char* K_lds = lds + 2 * SHM_V;
  LAS float* ws = (LAS float*)(lds + 2 * SHM_V + 2 * SHM_K) + wid * 64; LAS float* li_l = ws; LAS float* al_l = ws + 32;
  float m_reg = -1e30f, l_reg = 0; f32x16 o[4] = {}; bf16x8 qr[8];
  const bf16_t* Qw = Qb + (long)(wid * QBLK + r32) * LDQ + hi * 8;
#pragma unroll
  for (int d0 = 0; d0 < 8; ++d0) qr[d0] = ldg<bf16x8>(Qw + d0 * 16);
  const int sr = tid >> 4, sc = (tid & 15) * 8, vst0 = v_st(sr, sc), vst1 = v_st(32 + sr, sc);
  const int vb0 = (int)(unsigned)(uintptr_t)V_lds + v_rd_base(lane);
  struct { bf16x8 vs0, vs1, ks0, ks1; } sr_[1];
  const unsigned kvoff = (unsigned)(sr * LDK + sc) * 2u;
#define SLOAD(i, k0) do { const char* vt_ = (const char*)(Vh + (long)(k0) * LDK); const char* kt_ = (const char*)(Kh + (long)(k0) * LDK); \
    sr_[i].vs0 = ldg<bf16x8>(vt_ + kvoff); sr_[i].vs1 = ldg<bf16x8>(vt_ + 32 * LDK * 2 + kvoff); \
    sr_[i].ks0 = ldg<bf16x8>(kt_ + kvoff); sr_[i].ks1 = ldg<bf16x8>(kt_ + 32 * LDK * 2 + kvoff); } while (0)
#define SWRITE(b, i) do { *(LAS bf16x8*)(V_lds + (b) * SHM_V + vst0) = sr_[i].vs0;          \
    *(LAS bf16x8*)(V_lds + (b) * SHM_V + vst1) = sr_[i].vs1; int kc = sc * 2;               \
    *(LAS bf16x8*)(K_lds + (b) * SHM_K + KSWZ(sr, kc)) = sr_[i].ks0;                       \
    *(LAS bf16x8*)(K_lds + (b) * SHM_K + KSWZ(32 + sr, kc)) = sr_[i].ks1; } while (0)
#define SWAIT() asm volatile("s_waitcnt vmcnt(0)" ::: "memory")
#define RESC(a) do { if (__any((a) < 1.f)) { if (hi == 0) al_l[r32] = (a); asm volatile("s_waitcnt lgkmcnt(0)" ::: "memory"); \
    for (int d = 0; d < 4; ++d) for (int r = 0; r < 16; ++r) o[d][r] *= al_l[crow(r, hi)]; } } while (0)
  f32x16 pA0, pA1, pB0, pB1; float mnA, mnB, alA, alB; bf16x8 pa0, pa1, pa2, pa3; const int NT = seq / KVBLK;
  constexpr int SE = 0, SO = 0;
  SLOAD(SE, 0); asm volatile("s_waitcnt vmcnt(0)" ::: "memory"); SWRITE(0, SE); __syncthreads();
  qkt(pA0, pA1, K_lds, qr, r32, hi); partialSM(pA0, pA1, m_reg, mnA, alA);
  SLOAD(SO, KVBLK);
  SWAIT(); SWRITE(1, SO); __syncthreads();
  for (int j = 1; j + 1 < NT; j += 2) {
    SBAR(); qkt(pB0, pB1, K_lds + SHM_K, qr, r32, hi);
    finishSM(pA0, pA1, alA, l_reg, pa0, pa1, pa2, pa3); SBAR();
    SLOAD(SO, (j + 1) * KVBLK); SBAR();
    pv_d0(o, vb0, pa0, pa1, pa2, pa3); partialSM(pB0, pB1, m_reg, mnB, alB);
    __syncthreads(); SWAIT(); SWRITE(0, SE);
    RESC(alB); __syncthreads();
    SBAR(); qkt(pA0, pA1, K_lds, qr, r32, hi);
    finishSM(pB0, pB1, alB, l_reg, pa0, pa1, pa2, pa3); SBAR();
    SLOAD(SE, (j + 2) * KVBLK); SBAR();
    pv_d0(o, vb0 + (int)SHM_V, pa0, pa1, pa2, pa3); partialSM(pA0, pA1, m_reg, mnA, alA);
    __syncthreads(); SWAIT(); SWRITE(1, SO);
    RESC(alA); __syncthreads();
  }
  SBAR(); qkt(pB0, pB1, K_lds + SHM_K, qr, r32, hi);
  finishSM(pA0, pA1, alA, l_reg, pa0, pa1, pa2, pa3); SBAR();
  pv_d0(o, vb0, pa0, pa1, pa2, pa3); partialSM(pB0, pB1, m_reg, mnB, alB);
  __syncthreads(); RESC(alB);
  finishSM(pB0, pB1, alB, l_reg, pa0, pa1, pa2, pa3); SBAR();
  pv_d0(o, vb0 + (int)SHM_V, pa0, pa1, pa2, pa3);
  if (hi == 0) li_l[r32] = l_reg; asm volatile("s_waitcnt lgkmcnt(0)" ::: "memory");
  float rli[16];
#pragma unroll
  for (int r = 0; r < 16; ++r) rli[r] = __builtin_amdgcn_rcpf(li_l[crow(r, hi)]);
  bf16_t* Ow = Ob + (long)(wid * QBLK) * LDO;
#pragma unroll
  for (int r = 0; r < 16; ++r) { int orow = crow(r, hi);
    for (int d0 = 0; d0 < 4; ++d0) stg<bf16_t>(Ow + (long)orow * LDO + d0 * 32 + r32, (bf16_t)f2bf(o[d0][r] * rli[r])); }
#undef SLOAD
#undef SWRITE
#undef SWAIT
#undef RESC
}
}

constexpr int NWAVES = 8, NTHREADS = 512;
constexpr int RING_BYTES = 131072, LDSCTL_OFF = RING_BYTES, LDS_BYTES = 147456;

struct Args { const float* in[25]; float* out; unsigned char* ws; int ph_lo, ph_hi; };
enum { I_XP = 0, I_XS, I_CK, I_CV, I_ST, I_C, I_CCTX, I_ADAW, I_ADAB, I_NG, I_FWI, I_FWO, I_MWI, I_PW, I_PS, I_QKG, I_MWO, I_SWI, I_CW, I_CB, I_DTB, I_ALOG, I_SD, I_SNG, I_SWO };

typedef const float* const __attribute__((address_space(4)))* KinPtr;
struct Ctx {
    int tid, lane, wave, G, gw, NGW, bid;
    unsigned char* ws; KinPtr in; float* out;
    unsigned char* lds;
};

__device__ __forceinline__ Ctx relaunder(const Ctx& X0) {
    Ctx X = X0; int wv = X0.wave; asm volatile("" : "+s"(wv)); int ln; asm volatile("v_mbcnt_lo_u32_b32 %0, -1, 0\n\tv_mbcnt_hi_u32_b32 %0, -1, %0" : "=v"(ln));
    int b = X0.bid; asm volatile("" : "+s"(b));
    unsigned char* w = X0.ws; asm volatile("" : "+s"(w)); X.ws = w;
    KinPtr ki = X0.in; asm volatile("" : "+s"(ki)); X.in = ki;
    X.tid = wv * 64 + ln; X.lane = ln; X.wave = wv; X.bid = b; X.gw = b * NWAVES + wv; return X;
}
struct CvJob { const float* src; bf16_t* dst; int N, ldt, r0, k0, n0; };
constexpr int CV_FI = 32 * 352, CV_FO = 88 * 64, CV_MI = 32 * 80, CV_MO = 32 * 64, CV_PL = 4 * 8, CV_SI = 32 * 324, CV_SO = 64 * 64;
constexpr int CV_E0 = CV_FI + CV_FO;
constexpr int CV_E1 = CV_E0 + CV_MI + CV_MO + 4 * CV_PL;
constexpr int CV_E2 = CV_E1 + CV_FI + CV_FO;
constexpr int CV_E3 = CV_E2 + CV_FI + CV_FO;
constexpr int CV_E4 = CV_E3 + CV_SI + CV_SO;
constexpr int CV_E5 = CV_E4 + CV_FI;
constexpr int CV_TOTAL = CV_E5 + CV_FO;
__device__ __forceinline__ CvJob cv_mat(const float* W, int K, int N, bf16_t* WT, int ldt, int mode, int item) {
    const int nblk = N / 32, kb = item / nblk, nb = item - kb * nblk, n0 = 32 * nb;
    int r0 = n0; if (mode == 1) r0 = (n0 < DFF) ? ((n0 >> 7) * 256 + (n0 & 127)) : ((((n0 - DFF) >> 7) * 256) + 128 + ((n0 - DFF) & 127));
    (void)K; return CvJob{W, WT, N, ldt, r0, 64 * kb, n0};
}
__device__ __forceinline__ CvJob cv_ffn(const Ctx& X, int w, int r) {
    if (r < CV_FI) return cv_mat(X.in[I_FWI] + (size_t)w * DM * 2 * DFF, DM, 2 * DFF, (bf16_t*)(X.ws + WS_W1T) + (size_t)w * 2 * DFF * DM, DM, 1, r);
    return cv_mat(X.in[I_FWO] + (size_t)w * DFF * DM, DFF, DM, (bf16_t*)(X.ws + WS_W2T) + (size_t)w * DM * DFF, DFF, 0, r - CV_FI);
}
__device__ __forceinline__ CvJob cv_job(const Ctx& X, int it) {
    if (it < CV_E0) return cv_ffn(X, 0, it);
    if (it < CV_E1) { int r = it - CV_E0;
        if (r < CV_MI) return cv_mat(X.in[I_MWI], DM, MIXIN, (bf16_t*)(X.ws + WS_WMI), DM, 0, r); r -= CV_MI;
        if (r < CV_MO) return cv_mat(X.in[I_MWO], DM, DM, (bf16_t*)(X.ws + WS_WMO), DM, 0, r); r -= CV_MO;
        const int gq = r / CV_PL; return cv_mat(X.in[I_PW] + (size_t)gq * 65536, 256, 256, (bf16_t*)(X.ws + WS_WPL) + (size_t)gq * 65536, 256, 0, r - gq * CV_PL); }
    if (it < CV_E2) return cv_ffn(X, 1, it - CV_E1);
    if (it < CV_E3) return cv_ffn(X, 2, it - CV_E2);
    if (it < CV_E4) { int r = it - CV_E3;
        if (r < CV_SI) return cv_mat(X.in[I_SWI], DM, 10368, (bf16_t*)(X.ws + WS_WSI), DM, 0, r);
        return cv_mat(X.in[I_SWO], DINNER, DM, (bf16_t*)(X.ws + WS_WSO), DINNER, 0, r - CV_SI); }
    if (it < CV_E5) return cv_mat(X.in[I_FWI] + (size_t)3 * DM * 2 * DFF, DM, 2 * DFF, (bf16_t*)(X.ws + WS_W1T) + (size_t)3 * 2 * DFF * DM, DM, 1, it - CV_E4);
    return cv_mat(X.in[I_FWO] + (size_t)3 * DFF * DM, DFF, DM, (bf16_t*)(X.ws + WS_W2T) + (size_t)3 * DM * DFF, DFF, 0, it - CV_E5);
}
__device__ __forceinline__ void cv_load(const CvJob& J, int lane, float (&v)[32]) {
    const float* wp = J.src + (size_t)(J.k0 + (lane >> 5)) * J.N + J.n0 + (lane & 31);
#pragma unroll
    for (int i = 0; i < 32; ++i) v[i] = ldg<float>(wp + (size_t)(2 * i) * J.N);
}
__device__ __forceinline__ void cv_emit(const CvJob& J, int lane, const float (&v)[32], LAS float* scr) {
#pragma unroll
    for (int i = 0; i < 32; ++i) scr[(2 * i + (lane >> 5)) * 33 + (lane & 31)] = v[i];
    asm volatile("s_waitcnt lgkmcnt(0)" ::: "memory");
    const int c = lane & 7;
#pragma unroll
    for (int j = 0; j < 4; ++j) { const int n = (lane >> 3) + 8 * j; const LAS float* sp = scr + (8 * c) * 33 + n;
        u32x4 o; o.x = pk2(sp[0 * 33], sp[1 * 33]); o.y = pk2(sp[2 * 33], sp[3 * 33]); o.z = pk2(sp[4 * 33], sp[5 * 33]); o.w = pk2(sp[6 * 33], sp[7 * 33]);
        stg<u32x4>(J.dst + (size_t)(J.r0 + n) * J.ldt + J.k0 + 8 * c, o); }
    asm volatile("s_waitcnt lgkmcnt(0)" ::: "memory");
}
__device__ __forceinline__ void conv_range(const Ctx& X, int lo, int hi, int slot, int nslots) {
    LAS float* scr = (LAS float*)((LAS unsigned char*)X.lds + X.wave * 16384);
    for (int it = lo + slot; it < hi; it += 2 * nslots) {
        const int it2 = it + nslots; const bool two = it2 < hi;
        const CvJob A = cv_job(X, it), B = cv_job(X, two ? it2 : it);
        float va[32], vb[32];
        cv_load(A, X.lane, va); if (two) cv_load(B, X.lane, vb);
        cv_emit(A, X.lane, va, scr); if (two) cv_emit(B, X.lane, vb, scr);
    }
}
constexpr int CVQ0 = 39936, CVQ1 = CVQ0 + 11520, CVQ2 = CVQ1 + 1856, CVQ3 = CVQ2 + 11520, CVQ4 = CVQ3 + 11520, CVQ5 = CVQ4 + 4800;
static_assert(CVQ0 >= CV_E1 && CVQ2 >= CV_E2 && CVQ3 >= CV_E3 && CVQ4 >= CV_E4 && CVQ5 >= CV_E5 && CVQ5 <= CV_TOTAL, "every weight copy is finished at least one grid barrier before its first use");
__device__ __forceinline__ void conv_tail(const Ctx& X, int nwg, int lo, int hi) {
    const int rem = nwg % X.G; if (X.bid < rem) return;
    conv_range(X, lo, hi, (X.bid - rem) * NWAVES + X.wave, (X.G - rem) * NWAVES);
}
__device__ __forceinline__ void ph_prologue(const Ctx& X0) {
    const Ctx X = relaunder(X0);
    LAS unsigned char* lds3 = (LAS unsigned char*)X.lds;
    {
        LAS float* sc = (LAS float*)lds3;
        LAS float* red = (LAS float*)lds3;
        for (int it = X.bid; it < 256; it += X.G) {
            for (int e = X.tid; e < 2048 * 9; e += NTHREADS) { const int k = e / 9, ci = e % 9;
                const float v = (ci == 0) ? X.in[I_CCTX][k] : X.in[I_C][(ci - 1) * DM + k]; sc[k * 12 + ci] = silu_f(v); }
            __syncthreads();
            const int l = it / 128, c0 = (it % 128) * 144;
            const int cg = X.tid % 36, kp = X.tid / 36;
            float acc[9][4];
#pragma unroll
            for (int ci = 0; ci < 9; ++ci)
#pragma unroll
                for (int j = 0; j < 4; ++j) acc[ci][j] = 0.f;
            if (kp < 14) {
                const int kbeg = kp * 147, kend = (kbeg + 147 < 2048) ? kbeg + 147 : 2048;
                const float* wp = X.in[I_ADAW] + (size_t)l * DM * NMODS + c0 + cg * 4;
#pragma unroll 4
                for (int k = kbeg; k < kend; ++k) {
                    const f32x4 w = ldg<f32x4>(wp + (size_t)k * NMODS);
                    const f32x4 s0 = *(const LAS f32x4*)(sc + k * 12), s1 = *(const LAS f32x4*)(sc + k * 12 + 4); const float s8 = sc[k * 12 + 8];
#pragma unroll
                    for (int j = 0; j < 4; ++j) {
                        acc[0][j] += s0[0] * w[j]; acc[1][j] += s0[1] * w[j]; acc[2][j] += s0[2] * w[j]; acc[3][j] += s0[3] * w[j];
                        acc[4][j] += s1[0] * w[j]; acc[5][j] += s1[1] * w[j]; acc[6][j] += s1[2] * w[j]; acc[7][j] += s1[3] * w[j]; acc[8][j] += s8 * w[j]; }
                }
            }
            __syncthreads();
            if (kp < 14) {
#pragma unroll
                for (int ci = 0; ci < 9; ++ci)
#pragma unroll
                    for (int j = 0; j < 4; ++j) red[(kp * 9 + ci) * 144 + cg * 4 + j] = acc[ci][j];
            }
            __syncthreads();
#pragma unroll
            for (int q = 0; q < 3; ++q) { const int o = X.tid + q * NTHREADS; if (o < 1296) { float s = 0.f; for (int pp = 0; pp < 14; ++pp) s += red[pp * 1296 + o];
                const int ci = o / 144, cc = o % 144;
                ((float*)(X.ws + WS_MODS))[((size_t)l * 9 + ci) * NMODS + c0 + cc] = s + X.in[I_ADAB][(size_t)l * NMODS + c0 + cc]; } }
            __syncthreads();
        }
    }
    if (X.bid == X.G - 1 && X.wave == 0 && X.lane < 32) {
        double f = 1.0; for (int i = 0; i < X.lane; ++i) f *= 0.74989420933245582730;
        double c1 = 1.0, s1 = f, term_c = 1.0, term_s = f;
        for (int n = 1; n < 14; ++n) { term_c *= -f * f / ((2.0 * n - 1.0) * (2.0 * n)); term_s *= -f * f / ((2.0 * n) * (2.0 * n + 1.0)); c1 += term_c; s1 += term_s; }
        double c = 1.0, s = 0.0; float* rc = (float*)(X.ws + WS_ROPE); float* rs = rc + 64 * 32;
        for (int pos = 0; pos < 64; ++pos) { rc[pos * 32 + X.lane] = (float)c; rs[pos * 32 + X.lane] = (float)s; const double cn = c * c1 - s * s1, sn = s * c1 + c * s1; c = cn; s = sn; }
    }
    {
        bf16_t* KS = (bf16_t*)(X.ws + WS_KS); bf16_t* VS = (bf16_t*)(X.ws + WS_VS);
        const int n4 = 8 * 512 * 2 * 128 / 4;
        for (int e = X.bid * NTHREADS + X.tid; e < 2 * n4; e += X.G * NTHREADS) {
            const int which = e / n4, q = e % n4, el = q * 4;
            const int d = el & 127, kvh = (el >> 7) & 1, s = (el >> 8) & 511, b = el >> 17;
            const f32x4 v = ldg<f32x4>((which ? X.in[I_CV] : X.in[I_CK]) + el);
            u32x2 w; w.x = pk2(v[0], v[1]); w.y = pk2(v[2], v[3]);
            stg<u32x2>((which ? VS : KS) + ((size_t)(b * 2 + kvh) * 1536 + s) * 128 + d, w);
        }
        u32x4* z = (u32x4*)(X.ws + WS_WSI + (size_t)10368 * DM * 2);
        for (int e = X.bid * NTHREADS + X.tid; e < 128 * DM * 2 / 16; e += X.G * NTHREADS) z[e] = (u32x4){0u, 0u, 0u, 0u};
    }
    conv_range(X, 0, CVQ0, X.gw, X.NGW);
}
template <bool HAS_RES, bool HAS_U, bool HIN_F32, bool HOUT_F32>
__device__ __forceinline__ void ph_row(const Ctx& X0, const float* hin_p, const float* hin_s, float* hout, bf16_t* Hb, const bf16_t* Y, float wres,
                                       const float* gate, const float* g_post, const float* shift, const float* scale, const float* g_pre, bf16_t* U) {
    const Ctx X = relaunder(X0);
    LAS float* Lg = (LAS float*)X.lds;
    for (int e = X.tid; e < DM / 4; e += NTHREADS) {
        if (HAS_RES) *(LAS f32x4*)(Lg + e * 4) = ldg<f32x4>(g_post + e * 4);
        if (HAS_U) *(LAS f32x4*)(Lg + DM + e * 4) = ldg<f32x4>(g_pre + e * 4); }
    int ci_cur = -1;
    for (int m0 = X.bid * NWAVES; m0 < MTOK; m0 += X.NGW) {
        const int m = m0 + X.wave;
        const int ci = m0 < NP_TOK ? 0 : 1 + ((m0 - NP_TOK) >> 10);
        if (ci != ci_cur) {
            __syncthreads();
            for (int e = X.tid; e < DM / 4; e += NTHREADS) {
                if (HAS_RES) *(LAS f32x4*)(Lg + 2 * DM + e * 4) = ldg<f32x4>(gate + (size_t)ci * NMODS + e * 4);
                if (HAS_U) { *(LAS f32x4*)(Lg + 3 * DM + e * 4) = ldg<f32x4>(shift + (size_t)ci * NMODS + e * 4); *(LAS f32x4*)(Lg + 4 * DM + e * 4) = ldg<f32x4>(scale + (size_t)ci * NMODS + e * 4); } }
            __syncthreads(); ci_cur = ci;
        }
        f32x4 h[8];
        if (HIN_F32) { const float* hrow = (m < NP_TOK) ? hin_p + (size_t)m * DM : hin_s + (size_t)(m - NP_TOK) * DM;
#pragma unroll
            for (int j = 0; j < 8; ++j) h[j] = ldg<f32x4>(hrow + j * 256 + X.lane * 4); }
        else {
#pragma unroll
            for (int j = 0; j < 8; ++j) { const u32x2 hp = ldg<u32x2>(Hb + (size_t)m * DM + j * 256 + X.lane * 4); h[j] = (f32x4){bflo(hp.x), bfhi(hp.x), bflo(hp.y), bfhi(hp.y)}; } }
        if (HAS_RES) {
            f32x4 y[8]; float ss = 0.f; u32x2 p1[8];
#pragma unroll
            for (int j = 0; j < 8; ++j) p1[j] = (u32x2){0u, 0u};
            if (m0 >= 8192) {
#pragma unroll
                for (int j = 0; j < 8; ++j) p1[j] = ldg<u32x2>(Y + (size_t)MTOK * DM + (size_t)m * DM + j * 256 + X.lane * 4); }
#pragma unroll
            for (int j = 0; j < 8; ++j) { const u32x2 p0 = ldg<u32x2>(Y + (size_t)m * DM + j * 256 + X.lane * 4);
                y[j] = (f32x4){bflo(p0.x) + bflo(p1[j].x), bfhi(p0.x) + bfhi(p1[j].x), bflo(p0.y) + bflo(p1[j].y), bfhi(p0.y) + bfhi(p1[j].y)}; ss += (y[j][0] * y[j][0] + y[j][1] * y[j][1]) + (y[j][2] * y[j][2] + y[j][3] * y[j][3]); }
            const float r = 1.0f / sqrtf(wave_sum(ss, X.lane) * (1.0f / DM) + EPS);
#pragma unroll
            for (int j = 0; j < 8; ++j) { const int c = j * 256 + X.lane * 4;
                const f32x4 gt = *(const LAS f32x4*)(Lg + 2 * DM + c), gp = *(const LAS f32x4*)(Lg + c);
                h[j] = h[j] + (gt * wres) * (y[j] * r * gp);
                if (HOUT_F32) stg<f32x4>(hout + (size_t)m * DM + c, h[j]);
                else { u32x2 hw; hw.x = pk2(h[j][0], h[j][1]); hw.y = pk2(h[j][2], h[j][3]); stg<u32x2>(Hb + (size_t)m * DM + c, hw); } }
        }
        if (HAS_U) {
            float ss = 0.f;
#pragma unroll
            for (int j = 0; j < 8; ++j) ss += (h[j][0] * h[j][0] + h[j][1] * h[j][1]) + (h[j][2] * h[j][2] + h[j][3] * h[j][3]);
            const float r = 1.0f / sqrtf(wave_sum(ss, X.lane) * (1.0f / DM) + EPS);
#pragma unroll
            for (int j = 0; j < 8; ++j) { const int c = j * 256 + X.lane * 4;
                const f32x4 sh = *(const LAS f32x4*)(Lg + 3 * DM + c), sc = *(const LAS f32x4*)(Lg + 4 * DM + c), gp = *(const LAS f32x4*)(Lg + DM + c);
                const f32x4 u = (h[j] * r * gp) * (sc + 1.0f) + sh;
                u32x2 w; w.x = pk2(u[0], u[1]); w.y = pk2(u[2], u[3]);
                stg<u32x2>(U + (size_t)m * DM + c, w); }
        }
    }
    __syncthreads();
}

__device__ __forceinline__ void ph_mixpost(const Ctx& X0) {
    const Ctx X = relaunder(X0);
    const bf16_t* P = (const bf16_t*)(X.ws + WS_P);
    bf16_t* Q = (bf16_t*)(X.ws + WS_Q); bf16_t* KP = (bf16_t*)(X.ws + WS_KP); bf16_t* VP = (bf16_t*)(X.ws + WS_VP);
    bf16_t* KS = (bf16_t*)(X.ws + WS_KS); bf16_t* VS = (bf16_t*)(X.ws + WS_VS); bf16_t* Dd = (bf16_t*)(X.ws + WS_D);
    const float* rc = (const float*)(X.ws + WS_ROPE); const float* rs = rc + 64 * 32;
    const float* qkg = X.in[I_QKG];
    const int hsel = X.lane >> 5, l32 = X.lane & 31, half = l32 >> 4, ii = (l32 & 15) * 2, dA = half * 64 + ii;
    const f32x2n gq1 = ldg<f32x2n>(qkg + dA), gq2 = ldg<f32x2n>(qkg + dA + 32), gk1 = ldg<f32x2n>(qkg + 128 + dA), gk2 = ldg<f32x2n>(qkg + 128 + dA + 32);
    for (int m = X.gw; m < MTOK; m += X.NGW) {
        const bool smp = m >= NP_TOK; const int mm = smp ? m - NP_TOK : m; const int L = smp ? 1024 : 256; const int t = mm & (L - 1); const int b = smp ? (mm >> 10) : (mm >> 8);
        const int seq_base = m - t;
        const bf16_t* prow = P + (size_t)m * MIXIN;
        f32x2n cs = {1.f, 1.f}, sn = {0.f, 0.f};
        if (smp) { const int pos = half == 0 ? (t >> 6) : (t & 63); cs = ldg<f32x2n>(rc + pos * 32 + ii); sn = ldg<f32x2n>(rs + pos * 32 + ii); }
        f32x2n xa[5], xb[5];
        unsigned ra[5], rb[5];
#pragma unroll
        for (int p = 0; p < 4; ++p) { const bf16_t* sp = prow + 1024 + (2 * p + hsel) * 128 + dA; ra[p] = ldg<unsigned>(sp); rb[p] = ldg<unsigned>(sp + 32); }
        const bf16_t* kp = prow + 2048 + hsel * 128 + dA;
        ra[4] = ldg<unsigned>(kp); rb[4] = ldg<unsigned>(kp + 32);
        const unsigned rva = ldg<unsigned>(kp + 256), rvb = ldg<unsigned>(kp + 256 + 32);
        u32x2 own[4], win[30];
#pragma unroll
        for (int g = 0; g < 4; ++g) {
            const int w = 2 << g; const int lo0 = t - w / 2;
            own[g] = ldg<u32x2>(prow + g * 256 + X.lane * 4);
#pragma unroll
            for (int k = 0; k < w; ++k) { const int tt = lo0 + k; const int tc = tt < 0 ? 0 : (tt >= L ? L - 1 : tt);
                win[w - 2 + k] = ldg<u32x2>(P + (size_t)(seq_base + tc) * MIXIN + g * 256 + X.lane * 4); }
        }
        __builtin_amdgcn_sched_barrier(0);
#pragma unroll
        for (int p = 0; p < 5; ++p) { xa[p] = (f32x2n){bflo(ra[p]), bfhi(ra[p])}; xb[p] = (f32x2n){bflo(rb[p]), bfhi(rb[p])}; }
        const f32x2n va = {bflo(rva), bfhi(rva)}, vb = {bflo(rvb), bfhi(rvb)};
        float ss[5];
#pragma unroll
        for (int p = 0; p < 5; ++p) ss[p] = (xa[p][0] * xa[p][0] + xa[p][1] * xa[p][1]) + (xb[p][0] * xb[p][0] + xb[p][1] * xb[p][1]);
#pragma unroll
        for (int o = 1; o < 32; o <<= 1)
#pragma unroll
            for (int p = 0; p < 5; ++p) ss[p] += lane_xor(ss[p], X.lane, o);
#pragma unroll
        for (int p = 0; p < 4; ++p) {
            const float r = 1.0f / sqrtf(ss[p] * (1.0f / 128.0f) + EPS);
            const f32x2n x1 = xa[p] * r * gq1, x2 = xb[p] * r * gq2;
            const f32x2n o1 = x1 * cs - x2 * sn, o2 = x2 * cs + x1 * sn;
            bf16_t* qd = Q + (size_t)m * 1024 + (2 * p + hsel) * 128 + dA;
            stg<unsigned>(qd, pkbf(o1[0], o1[1])); stg<unsigned>(qd + 32, pkbf(o2[0], o2[1]));
        }
        {
            const float r = 1.0f / sqrtf(ss[4] * (1.0f / 128.0f) + EPS);
            const f32x2n x1 = xa[4] * r * gk1, x2 = xb[4] * r * gk2;
            if (!smp) {
                float* ko = X.out + OUT_K + (size_t)m * 256 + hsel * 128 + dA; float* vo = X.out + OUT_V + (size_t)m * 256 + hsel * 128 + dA;
                stg<f32x2n>(ko, x1); stg<f32x2n>(ko + 32, x2); stg<f32x2n>(vo, va); stg<f32x2n>(vo + 32, vb);
                const size_t o = ((size_t)(b * 2 + hsel) * 256 + t) * 128 + dA;
                stg<unsigned>(KP + o, pkbf(x1[0], x1[1])); stg<unsigned>(KP + o + 32, pkbf(x2[0], x2[1]));
                stg<unsigned>(VP + o, rva); stg<unsigned>(VP + o + 32, rvb);
            } else {
                const f32x2n o1 = x1 * cs - x2 * sn, o2 = x2 * cs + x1 * sn;
                const size_t o = ((size_t)(b * 2 + hsel) * 1536 + 512 + t) * 128 + dA;
                stg<unsigned>(KS + o, pkbf(o1[0], o1[1])); stg<unsigned>(KS + o + 32, pkbf(o2[0], o2[1]));
                stg<unsigned>(VS + o, rva); stg<unsigned>(VS + o + 32, rvb);
            }
        }
#pragma unroll
        for (int g = 0; g < 4; ++g) {
            const int w = 2 << g; const int lo0 = t - w / 2;
            int lo = lo0, hi = lo0 + w; lo = lo < 0 ? 0 : lo; hi = hi > L ? L : hi;
            f32x4 s = {0.f, 0.f, 0.f, 0.f};
#pragma unroll
            for (int k = 0; k < w; ++k) { const int tt = lo0 + k; const bool ok = tt >= 0 && tt < L;
                const u32x2 wk = win[w - 2 + k]; s += ok ? (f32x4){bflo(wk.x), bfhi(wk.x), bflo(wk.y), bfhi(wk.y)} : (f32x4){0.f, 0.f, 0.f, 0.f}; }
            const float inv = 1.0f / (float)(hi - lo);
            const f32x4 d = s * inv - (f32x4){bflo(own[g].x), bfhi(own[g].x), bflo(own[g].y), bfhi(own[g].y)};
            u32x2 wv; wv.x = pk2(d[0], d[1]); wv.y = pk2(d[2], d[3]);
            stg<u32x2>(Dd + (size_t)m * 1024 + g * 256 + X.lane * 4, wv);
        }
    }
}

__device__ __forceinline__ void ph_conv(const Ctx& X0) {
    const Ctx X = relaunder(X0);
    const bf16_t* Z = (const bf16_t*)(X.ws + WS_ZXB); bf16_t* XBC = (bf16_t*)(X.ws + WS_XBC);
    const float* DT = (const float*)(X.ws + WS_DT); float* DTS = (float*)(X.ws + WS_DTS);
    const float* dtb = X.in[I_DTB];
    LAS float* cw = (LAS float*)X.lds; LAS float* cb = cw + CONVD * 3;
    for (int e = X.tid; e < CONVD * 3 / 4; e += NTHREADS) *(LAS f32x4*)(cw + e * 4) = ldg<f32x4>(X.in[I_CW] + e * 4);
    for (int e = X.tid; e < CONVD / 4; e += NTHREADS) *(LAS f32x4*)(cb + e * 4) = ldg<f32x4>(X.in[I_CB] + e * 4);
    __syncthreads();
    for (int m = X.gw; m < MTOK; m += X.NGW) {
        const bool smp = m >= NP_TOK; const int mm = smp ? m - NP_TOK : m; const int L = smp ? 1024 : 256; const int t = mm & (L - 1);
        const bool hasm = t > 0, hasp = t < L - 1;
        const bf16_t* r0 = Z + (size_t)m * ZXB_LD + 4096 + X.lane * 8;
        const bf16_t* rm = hasm ? r0 - ZXB_LD : r0; const bf16_t* rp = hasp ? r0 + ZXB_LD : r0;
        const u32x4 z4 = {0u, 0u, 0u, 0u};
#pragma unroll 1
        for (int ib = 0; ib < 3; ++ib) {
            u32x4 x0[4], xm[4], xp[4];
#pragma unroll
            for (int k = 0; k < 4; ++k) { const int cc = (ib * 4 + k) * 512; x0[k] = ldg<u32x4>(r0 + cc); xm[k] = ldg<u32x4>(rm + cc); xp[k] = ldg<u32x4>(rp + cc); }
#pragma unroll
            for (int k = 0; k < 4; ++k) {
                const int c0 = (ib * 4 + k) * 512 + X.lane * 8;
                const u32x4 vm = hasm ? xm[k] : z4, vp = hasp ? xp[k] : z4;
                float wv[24], bv[8];
#pragma unroll
                for (int q = 0; q < 6; ++q) { const f32x4 t4 = *(const LAS f32x4*)(cw + c0 * 3 + q * 4); wv[q * 4] = t4[0]; wv[q * 4 + 1] = t4[1]; wv[q * 4 + 2] = t4[2]; wv[q * 4 + 3] = t4[3]; }
#pragma unroll
                for (int q = 0; q < 2; ++q) { const f32x4 t4 = *(const LAS f32x4*)(cb + c0 + q * 4); bv[q * 4] = t4[0]; bv[q * 4 + 1] = t4[1]; bv[q * 4 + 2] = t4[2]; bv[q * 4 + 3] = t4[3]; }
                float o[8];
#pragma unroll
                for (int j = 0; j < 8; ++j) {
                    const unsigned wm = vm[j >> 1], w0 = x0[k][j >> 1], wp = vp[j >> 1];
                    const float am = (j & 1) ? bfhi(wm) : bflo(wm), a0 = (j & 1) ? bfhi(w0) : bflo(w0), ap = (j & 1) ? bfhi(wp) : bflo(wp);
                    o[j] = silu_f(am * wv[j * 3] + a0 * wv[j * 3 + 1] + ap * wv[j * 3 + 2] + bv[j]);
                }
                u32x4 w; w.x = pk2(o[0], o[1]); w.y = pk2(o[2], o[3]); w.z = pk2(o[4], o[5]); w.w = pk2(o[6], o[7]);
                stg<u32x4>(XBC + (size_t)m * CONVD + c0, w);
            }
        }
#pragma unroll
        for (int jj = 0; jj < 2; ++jj) { const int j = X.lane + 64 * jj; const float v = DT[(size_t)m * 128 + j] + dtb[j];
            DTS[(size_t)m * 128 + j] = fmaxf(v, 0.f) + log1pf(__expf(-fabsf(v))); }
    }
}

namespace ssd {
using s16x4 = __attribute__((ext_vector_type(4))) short;
__device__ __forceinline__ s16x4 tr_read(const LAS unsigned char* p) { return __builtin_amdgcn_ds_read_tr16_b64_v4i16((LAS s16x4*)p); }
__device__ __forceinline__ void glds16(const void* gsrc, unsigned lds_dst) { unsigned keep;
    asm volatile("s_mov_b32 %0, m0\n\ts_mov_b32 m0, %2\n\ts_nop 0\n\tglobal_load_lds_dwordx4 %1, off\n\ts_mov_b32 m0, %0" : "=&s"(keep) : "v"(gsrc), "s"(lds_dst) : "memory"); }
__device__ __forceinline__ f32x4 mfma16(bf16x8 a, bf16x8 b, f32x4 c) { return __builtin_amdgcn_mfma_f32_16x16x32_bf16(a, b, c, 0, 0, 0); }
__device__ __forceinline__ unsigned cvtpk(float lo, float hi) { return pkbf(lo, hi); }
}
__device__ __forceinline__ void ph_ssd(const Ctx& X0) {
    const Ctx X = relaunder(X0);
    const bf16_t* XBC = (const bf16_t*)(X.ws + WS_XBC); const float* DTS = (const float*)(X.ws + WS_DTS);
    LAS unsigned char* L = (LAS unsigned char*)X.lds;
    const unsigned Lb = (unsigned)(uintptr_t)L;
    const int lane = X.lane, w = X.wave, q = lane >> 4, r16 = lane & 15, li = lane & 31;
    const int hl = w >> 1, ph = w & 1;
    LAS float* arr0 = (LAS float*)(L + 65536 + w * 1024);
    const int trq = (lane & 15) >> 2, trp = lane & 3;
    const int trrow = 4 * q + trq;
    const bool isx = w >= 4;
    const int dstw = isx ? 16384 + (w - 4) * 4096 : (w >> 1) * 8192 + (w & 1) * 4096;
    unsigned voff[4];
#pragma unroll
    for (int k = 0; k < 4; ++k) { const int row = isx ? 8 * (w - 4) + 2 * k + (lane >> 5) : 16 * (w & 1) + 4 * k + (lane >> 4);
        const int c = isx ? ((lane & 31) ^ (row & 15)) : ((lane & 15) ^ (row & 15)); voff[k] = (unsigned)(row * CONVD + c * 8) * 2u; }
    for (int it = X.bid; it < 768; it += X.G) {
        const bool smp = it < 256; const int v = smp ? it : it - 256;
        const int bq = v >> 5, rest = v & 31, g = rest >> 2, gh = (rest >> 1) & 1, d_rt = rest & 1;
#pragma unroll
      for (int D = 0; D < 2; ++D) {
        if (d_rt != D) continue;
        const int d = D;
        const int bg = smp ? 16 + bq : bq;
        const int Lseq = smp ? 1024 : 256; const int base = smp ? NP_TOK + bq * 1024 : bq * 256;
        const int h = 8 * g + 4 * gh + hl;
        const float A = -__expf(X.in[I_ALOG][d * 64 + h]);
        const float dskip = d == 0 ? X.in[I_SD][h] + X.in[I_SD][64 + h] : 0.f;
        bf16_t* Yd = (bf16_t*)(X.ws + (d ? WS_YB : WS_YF));
        f32x4 hT[8][2];
        if (smp) { const float* s0 = X.in[I_ST] + (((size_t)bq * 2 + d) * 64 + h) * 8192;
#pragma unroll
            for (int nt = 0; nt < 8; ++nt)
#pragma unroll
                for (int pt = 0; pt < 2; ++pt) hT[nt][pt] = ldg<f32x4>(s0 + (size_t)(32 * ph + 16 * pt + r16) * 128 + 16 * nt + 4 * q); }
        else {
#pragma unroll
            for (int nt = 0; nt < 8; ++nt)
#pragma unroll
                for (int pt = 0; pt < 2; ++pt) hT[nt][pt] = (f32x4){0.f, 0.f, 0.f, 0.f}; }
        const int nsteps = Lseq >> 5;
        const unsigned ylane = (unsigned)((4 * q) * DINNER + 32 * ph + r16) * 2u;
        const int colbase = isx ? (8 * g + 4 * gh) * 64 : ((w >> 1) ? 4096 : 5120) + g * 128;
#define SSD_ISSUE(t0_, b_) do { const char* sb_ = (const char*)(XBC + (size_t)(base + (t0_)) * CONVD + colbase); \
            _Pragma("unroll") for (int k_ = 0; k_ < 4; ++k_) ssd::glds16(sb_ + voff[k_], Lb + (unsigned)((b_) * 32768 + dstw + k_ * 1024)); } while (0)
#define SSD_SCAN(dtv_, par_, tot_) do { float a_ = (dtv_) * A; \
            _Pragma("unroll") for (int o_ = 1; o_ < 32; o_ <<= 1) { const int src_ = d == 0 ? li - o_ : li + o_; \
                const float t_ = __builtin_bit_cast(float, __builtin_amdgcn_ds_bpermute(((lane & 32) | (src_ & 31)) << 2, __builtin_bit_cast(int, a_))); \
                if (src_ >= 0 && src_ < 32) a_ += t_; } \
            (tot_) = __builtin_bit_cast(float, d == 0 ? __builtin_amdgcn_readlane(__builtin_bit_cast(int, a_), 31) : __builtin_amdgcn_readlane(__builtin_bit_cast(int, a_), 0)); \
            LAS float* ar_ = arr0 + (par_) * 128; ar_[li] = a_; ar_[32 + li] = __expf(a_); ar_[64 + li] = (dtv_) * __expf((tot_) - a_); ar_[96 + li] = (dtv_); } while (0)
        float tot_cur;
        { const int t0 = d == 0 ? 0 : Lseq - 32; SSD_ISSUE(t0, 0); const float dt0 = ldg<float>(DTS + (size_t)(base + t0 + li) * 128 + d * 64 + h); SSD_SCAN(dt0, 0, tot_cur); }
        for (int s2 = 0; s2 < nsteps; s2 += 2) {
#pragma unroll
          for (int par = 0; par < 2; ++par) {
            const int s = s2 + par;
            const int t0 = d == 0 ? s * 32 : Lseq - 32 - s * 32;
            if (s == 0) asm volatile("s_waitcnt vmcnt(0)" ::: "memory"); else asm volatile("s_waitcnt vmcnt(16)" ::: "memory");
            __syncthreads(); asm volatile("" ::: "memory");
            float dt_nx = 0.f;
            if (s + 1 < nsteps) { const int t1 = d == 0 ? t0 + 32 : t0 - 32; SSD_ISSUE(t1, par ^ 1); dt_nx = ldg<float>(DTS + (size_t)(base + t1 + li) * 128 + d * 64 + h); }
            LAS float* a_s = arr0 + par * 128; LAS float* ea_s = a_s + 32; LAS float* sc_s = a_s + 64; LAS float* dt_s = a_s + 96;
            const float tot = tot_cur;
            LAS unsigned char* Bf = L + par * 32768;
            f32x4 cbt[2][2];
#pragma unroll
            for (int jt = 0; jt < 2; ++jt)
#pragma unroll
                for (int it2 = 0; it2 < 2; ++it2) cbt[jt][it2] = (f32x4){0.f, 0.f, 0.f, 0.f};
#pragma unroll
            for (int ks = 0; ks < 4; ++ks) {
                bf16x8 af[2], bfr[2];
#pragma unroll
                for (int t = 0; t < 2; ++t) { const int off = (16 * t + r16) * 256 + (((4 * ks + q) ^ r16) << 4);
                    af[t] = *(const LAS bf16x8*)(Bf + 8192 + off); bfr[t] = *(const LAS bf16x8*)(Bf + off); }
#pragma unroll
                for (int jt = 0; jt < 2; ++jt)
#pragma unroll
                    for (int it2 = 0; it2 < 2; ++it2) if (!(d == 0 ? (jt == 1 && it2 == 0) : (jt == 0 && it2 == 1))) cbt[jt][it2] = ssd::mfma16(af[jt], bfr[it2], cbt[jt][it2]);
            }
            f32x4 y[2][2];
#pragma unroll
            for (int it2 = 0; it2 < 2; ++it2)
#pragma unroll
                for (int pt = 0; pt < 2; ++pt) y[it2][pt] = (f32x4){0.f, 0.f, 0.f, 0.f};
#pragma unroll
            for (int ks = 0; ks < 4; ++ks) {
                bf16x8 ca[2], hb[2];
#pragma unroll
                for (int it2 = 0; it2 < 2; ++it2) { const int rowb = (16 * it2 + r16) * 256 + 8 * (q & 1);
                    const u32x2 lo = *(const LAS u32x2*)(Bf + rowb + (((4 * ks + (q >> 1)) ^ r16) << 4)), hi2 = *(const LAS u32x2*)(Bf + rowb + (((4 * ks + 2 + (q >> 1)) ^ r16) << 4));
                    u32x4 wv = {lo.x, lo.y, hi2.x, hi2.y}; ca[it2] = __builtin_bit_cast(bf16x8, wv); }
#pragma unroll
                for (int pt = 0; pt < 2; ++pt) { const f32x4 h0 = hT[2 * ks][pt], h1 = hT[2 * ks + 1][pt];
                    u32x4 wv = {ssd::cvtpk(h0[0], h0[1]), ssd::cvtpk(h0[2], h0[3]), ssd::cvtpk(h1[0], h1[1]), ssd::cvtpk(h1[2], h1[3])}; hb[pt] = __builtin_bit_cast(bf16x8, wv); }
#pragma unroll
                for (int it2 = 0; it2 < 2; ++it2)
#pragma unroll
                    for (int pt = 0; pt < 2; ++pt) y[it2][pt] = ssd::mfma16(ca[it2], hb[pt], y[it2][pt]);
            }
#pragma unroll
            for (int it2 = 0; it2 < 2; ++it2) { const f32x4 ea4 = *(const LAS f32x4*)(ea_s + 16 * it2 + 4 * q);
#pragma unroll
                for (int pt = 0; pt < 2; ++pt) y[it2][pt] = y[it2][pt] * ea4; }
            bf16x8 xf[2];
            {
                ssd::s16x4 x0[2], x1[2];
#pragma unroll
                for (int pt = 0; pt < 2; ++pt) { const int ch = hl * 8 + ph * 4 + 2 * pt + (trp >> 1);
                    const LAS unsigned char* ad = Bf + 16384 + (trrow * 512 + ((ch ^ (trrow & 15)) << 4) + 8 * (trp & 1));
                    x0[pt] = ssd::tr_read(ad); x1[pt] = ssd::tr_read(ad + 16 * 512); }
#pragma unroll
                for (int pt = 0; pt < 2; ++pt) xf[pt] = (bf16x8){x0[pt][0], x0[pt][1], x0[pt][2], x0[pt][3], x1[pt][0], x1[pt][1], x1[pt][2], x1[pt][3]};
            }
            const f32x4 aj0 = *(const LAS f32x4*)(a_s + 4 * q), aj1 = *(const LAS f32x4*)(a_s + 16 + 4 * q);
            const f32x4 dj0 = *(const LAS f32x4*)(dt_s + 4 * q), dj1 = *(const LAS f32x4*)(dt_s + 16 + 4 * q);
            int r16m = r16; asm volatile("" : "+v"(r16m));
            const int sgn = d == 0 ? 1 : -1;
            const int dq = d == 0 ? 4 * q - r16m : r16m - 4 * q;
#pragma unroll
            for (int it2 = 0; it2 < 2; ++it2) {
                const int i = 16 * it2 + r16m; const float ai = a_s[i];
                float wv[8];
#pragma unroll
                for (int e = 0; e < 4; ++e) {
                    const bool m0 = dq <= sgn * (16 * it2 - e), m1 = dq <= sgn * (16 * it2 - 16 - e);
                    const bool z0 = d == 1 && it2 == 1, f0 = d == 0 && it2 == 1, z1 = d == 0 && it2 == 0, f1 = d == 1 && it2 == 0;
                    wv[e] = z0 ? 0.f : ((f0 || m0) ? cbt[0][it2][e] * __expf(ai - aj0[e]) * dj0[e] : 0.f);
                    wv[4 + e] = z1 ? 0.f : ((f1 || m1) ? cbt[1][it2][e] * __expf(ai - aj1[e]) * dj1[e] : 0.f);
                }
                u32x4 ww = {ssd::cvtpk(wv[0], wv[1]), ssd::cvtpk(wv[2], wv[3]), ssd::cvtpk(wv[4], wv[5]), ssd::cvtpk(wv[6], wv[7])};
                const bf16x8 wf = __builtin_bit_cast(bf16x8, ww);
#pragma unroll
                for (int pt = 0; pt < 2; ++pt) y[it2][pt] = ssd::mfma16(wf, xf[pt], y[it2][pt]);
            }
#pragma unroll
            for (int pt = 0; pt < 2; ++pt) { const u32x4 xw = __builtin_bit_cast(u32x4, xf[pt]);
                y[0][pt] += dskip * (f32x4){bflo(xw.x), bfhi(xw.x), bflo(xw.y), bfhi(xw.y)}; y[1][pt] += dskip * (f32x4){bflo(xw.z), bfhi(xw.z), bflo(xw.w), bfhi(xw.w)}; }
            char* yst = (char*)Yd + ((size_t)(base + t0) * DINNER + h * 64) * 2;
            unsigned yl = ylane; asm volatile("" : "+v"(yl));
#pragma unroll
            for (int it2 = 0; it2 < 2; ++it2)
#pragma unroll
                for (int pt = 0; pt < 2; ++pt)
#pragma unroll
                    for (int r = 0; r < 4; r += 2) { const unsigned pk = pkbf(y[it2][pt][r], y[it2][pt][r + 1]);
                        stg<bf16_t>(yst + (yl + (unsigned)(((16 * it2 + r) * DINNER + 16 * pt) * 2)), (bf16_t)(pk & 0xffffu));
                        stg<bf16_t>(yst + (yl + (unsigned)(((16 * it2 + r + 1) * DINNER + 16 * pt) * 2)), (bf16_t)(pk >> 16)); }
            {
                const f32x4 s0 = *(const LAS f32x4*)(sc_s + 4 * q), s1 = *(const LAS f32x4*)(sc_s + 16 + 4 * q);
                bf16x8 xs[2];
#pragma unroll
                for (int pt = 0; pt < 2; ++pt) { const u32x4 xw = __builtin_bit_cast(u32x4, xf[pt]);
                    u32x4 o; o.x = ssd::cvtpk(bflo(xw.x) * s0[0], bfhi(xw.x) * s0[1]); o.y = ssd::cvtpk(bflo(xw.y) * s0[2], bfhi(xw.y) * s0[3]);
                    o.z = ssd::cvtpk(bflo(xw.z) * s1[0], bfhi(xw.z) * s1[1]); o.w = ssd::cvtpk(bflo(xw.w) * s1[2], bfhi(xw.w) * s1[3]); xs[pt] = __builtin_bit_cast(bf16x8, o); }
                const float et = __expf(tot);
#pragma unroll
                for (int nh = 0; nh < 2; ++nh) {
                    ssd::s16x4 b0[4], b1[4];
#pragma unroll
                    for (int k = 0; k < 4; ++k) { const int nt = nh * 4 + k; const int ch = 2 * nt + (trp >> 1);
                        const LAS unsigned char* ad = Bf + 8192 + (trrow * 256 + ((ch ^ (trrow & 15)) << 4) + 8 * (trp & 1));
                        b0[k] = ssd::tr_read(ad); b1[k] = ssd::tr_read(ad + 16 * 256); }
#pragma unroll
                    for (int k = 0; k < 4; ++k) { const int nt = nh * 4 + k;
                        const bf16x8 bt = (bf16x8){b0[k][0], b0[k][1], b0[k][2], b0[k][3], b1[k][0], b1[k][1], b1[k][2], b1[k][3]};
#pragma unroll
                        for (int pt = 0; pt < 2; ++pt) hT[nt][pt] = ssd::mfma16(bt, xs[pt], hT[nt][pt] * et); }
                }
            }
            if (s + 1 < nsteps) { float tn; SSD_SCAN(dt_nx, par ^ 1, tn); tot_cur = tn; }
          }
        }
#undef SSD_ISSUE
#undef SSD_SCAN
        if (!smp) { float* so = X.out + OUT_SSM + (((size_t)bg * 2 + d) * 64 + h) * 8192;
#pragma unroll
            for (int nt = 0; nt < 8; ++nt)
#pragma unroll
                for (int pt = 0; pt < 2; ++pt) stg<f32x4>(so + (size_t)(32 * ph + 16 * pt + r16) * 128 + 16 * nt + 4 * q, hT[nt][pt]); }
        __syncthreads();
      }
    }
}

__device__ __forceinline__ void ph_gatenorm(const Ctx& X0) {
    const Ctx X = relaunder(X0);
    const bf16_t* YF = (const bf16_t*)(X.ws + WS_YF); const bf16_t* YB = (const bf16_t*)(X.ws + WS_YB);
    const bf16_t* Z = (const bf16_t*)(X.ws + WS_ZXB);
    bf16_t* YN = (bf16_t*)(X.ws + WS_HID); const float* ng = X.in[I_SNG] + X.lane * 8;
    LAS float* yb = (LAS float*)((LAS unsigned char*)X.lds + X.wave * 16384) + X.lane * 8;
    f32x4 gv[16];
#pragma unroll
    for (int j = 0; j < 8; ++j) { gv[2 * j] = ldg<f32x4>(ng + j * 512); gv[2 * j + 1] = ldg<f32x4>(ng + j * 512 + 4); }
    for (int m = X.gw; m < MTOK; m += X.NGW) {
        const bf16_t* fp = YF + (size_t)m * DINNER + X.lane * 8; const bf16_t* bp = YB + (size_t)m * DINNER + X.lane * 8;
        const bf16_t* zp = Z + (size_t)m * ZXB_LD + X.lane * 8;
        float ss = 0.f;
        u32x4 fa[8], ba[8], za[8];
#pragma unroll
        for (int j = 0; j < 8; ++j) { fa[j] = ldg<u32x4>(fp + j * 512); ba[j] = ldg<u32x4>(bp + j * 512); za[j] = ldg<u32x4>(zp + j * 512); }
        __builtin_amdgcn_sched_barrier(0);
#pragma unroll
        for (int j = 0; j < 8; ++j) {
            const u32x4 f = fa[j], b = ba[j], z = za[j];
            float y[8];
#pragma unroll
            for (int k = 0; k < 4; ++k) {
                y[2 * k] = (bflo(f[k]) + bflo(b[k])) * silu_f(bflo(z[k]));
                y[2 * k + 1] = (bfhi(f[k]) + bfhi(b[k])) * silu_f(bfhi(z[k]));
                ss += y[2 * k] * y[2 * k] + y[2 * k + 1] * y[2 * k + 1]; }
            *(LAS f32x4*)(yb + j * 512) = (f32x4){y[0], y[1], y[2], y[3]}; *(LAS f32x4*)(yb + j * 512 + 4) = (f32x4){y[4], y[5], y[6], y[7]};
        }
        const float r = 1.0f / sqrtf(wave_sum(ss, X.lane) * (1.0f / DINNER) + EPS);
#pragma unroll
        for (int j = 0; j < 8; ++j) {
            const f32x4 g0 = gv[2 * j], g1 = gv[2 * j + 1];
            const f32x4 y0 = *(const LAS f32x4*)(yb + j * 512), y1 = *(const LAS f32x4*)(yb + j * 512 + 4);
            u32x4 o; o.x = pk2(y0[0] * r * g0[0], y0[1] * r * g0[1]); o.y = pk2(y0[2] * r * g0[2], y0[3] * r * g0[3]);
            o.z = pk2(y1[0] * r * g1[0], y1[1] * r * g1[1]); o.w = pk2(y1[2] * r * g1[2], y1[3] * r * g1[3]);
            stg<u32x4>(YN + (size_t)m * DINNER + j * 512 + X.lane * 8, o); }
    }
}

__device__ __forceinline__ void ph_attn(const Ctx& X0) {
    const Ctx X = relaunder(X0);
    const bf16_t* Q = (const bf16_t*)(X.ws + WS_Q); bf16_t* CAT = (bf16_t*)(X.ws + WS_CAT);
    const bf16_t* KP = (const bf16_t*)(X.ws + WS_KP); const bf16_t* VP = (const bf16_t*)(X.ws + WS_VP);
    const bf16_t* KS = (const bf16_t*)(X.ws + WS_KS); const bf16_t* VS = (const bf16_t*)(X.ws + WS_VS);
    for (int u = X.bid; u < 256 + 128; u += X.G) {
        const bool smp = u < 256; const int v = u - 256;
        const int b = smp ? (u >> 5) : (v >> 3), hh = smp ? ((u & 31) >> 2) : (v & 7), qb = smp ? (u & 3) : 0, kvh = hh >> 2;
        const size_t row0 = smp ? (size_t)NP_TOK + b * 1024 + qb * 256 : (size_t)b * 256;
        const int seq = smp ? 1536 : 256;
        const size_t kv0 = (size_t)(b * 2 + kvh) * seq * 128;
        const bf16_t* Kb = (smp ? KS : KP) + kv0; const bf16_t* Vb = (smp ? VS : VP) + kv0;
        att::attn_body<1024, 128, 2048>(Q + row0 * 1024 + hh * 128, Kb, Vb, CAT + row0 * 2048 + 1024 + hh * 128, seq, (LAS char*)X.lds, X.tid);
        __syncthreads();
    }
}

struct PhState { int pid, lo, hi; XcdBarrier bar; };
#define PH_BEGIN if (P.pid >= P.lo && P.pid < P.hi) { const Ctx XP = relaunder(X); (void)XP;
#define PH_END   if (P.pid + 1 < P.hi) xcd_barrier(P.bar, XP.tid == 0); } ++P.pid;
template <int L, int F>
__device__ __forceinline__ void sub_layer(const Ctx& X, PhState& P) {
    LAS unsigned char* lds3 = (LAS unsigned char*)X.lds;
    float* MODS = (float*)(X.ws + WS_MODS);
    bf16_t* H = (bf16_t*)(X.ws + WS_H); bf16_t* YB16 = (bf16_t*)(X.ws + WS_Y); const bf16_t* Y = YB16; bf16_t* U = (bf16_t*)(X.ws + WS_U); bf16_t* HID = (bf16_t*)(X.ws + WS_HID);
    const float* NG = X.in[I_NG];
        const float* mods = MODS + (size_t)L * 9 * NMODS;
        const float* ng = NG + (size_t)L * 6 * DM;
            PH_BEGIN {
                pg8::Gemm g{U, (const bf16_t*)(XP.ws + WS_W1T) + (size_t)(L * 2 + F) * 2 * DFF * DM, MTOK, 2 * DFF, DM, DM, DM, 0, 2 * DFF / 256, 0};
                pg8::StaticOrder S; S.init(MTOK, 2 * DFF, XP.G, XP.bid, 1);
                pg8::EpiSwiGLU E{HID, DFF};
                pg8::gemm_phase(lds3, g, S, E, XP.tid);
                if constexpr (L == 0 && F == 0) conv_tail(XP, (MTOK / 256) * (2 * DFF / 256), CVQ0, CVQ1);
                if constexpr (L == 0 && F == 1) conv_tail(XP, (MTOK / 256) * (2 * DFF / 256), CVQ2, CVQ3);
                if constexpr (L == 1 && F == 0) conv_tail(XP, (MTOK / 256) * (2 * DFF / 256), CVQ3, CVQ4);
                if constexpr (L == 1 && F == 1) conv_tail(XP, (MTOK / 256) * (2 * DFF / 256), CVQ5, CV_TOTAL);
            } PH_END
            PH_BEGIN {
                pg8::Gemm g{HID, (const bf16_t*)(XP.ws + WS_W2T) + (size_t)(L * 2 + F) * DM * DFF, MTOK, 2 * DM, DFF / 2, DFF, DFF, 0, DM / 256, (size_t)DFF};
                pg8::MixedOrder S; S.init(XP.G, XP.bid);
                pg8::EpiBf16Part E{YB16, DM, (size_t)MTOK * DM, DM / 256};
                pg8::gemm_phase(lds3, g, S, E, XP.tid);
            } PH_END
            if constexpr (F == 0) {
                PH_BEGIN {
                    ph_row<true, true, L == 0, false>(X, XP.in[I_XP], XP.in[I_XS], nullptr, H, Y, 0.5f, mods + 2 * DM, ng + 1 * DM, mods + 3 * DM, mods + 4 * DM, ng + 2 * DM, U);
                } PH_END
                if constexpr (L == 0) {
                    PH_BEGIN {
                        pg8::Gemm g{U, (const bf16_t*)(XP.ws + WS_WMI), MTOK, MIXIN, DM, DM, DM, 0, MIXIN / 256, 0};
                        pg8::StaticOrder S; S.init(MTOK, MIXIN, XP.G, XP.bid);
                        pg8::EpiBf16S E{(bf16_t*)(XP.ws + WS_P), MIXIN, nullptr};
                        pg8::gemm_phase(lds3, g, S, E, XP.tid);
                        conv_tail(XP, (MTOK / 256) * (MIXIN / 256), CVQ1, CVQ2);
                    } PH_END
                    PH_BEGIN ph_mixpost(X); PH_END
                    PH_BEGIN {
                        ph_attn(X);
                    }
                    {
                        const Ctx XP = relaunder(X);
                        pg8::Gemm g{(const bf16_t*)(XP.ws + WS_D), (const bf16_t*)(XP.ws + WS_WPL), MTOK, 1024, 256, 1024, 256, 512, 4, 0};
                        pg8::StaticOrder S; S.init(MTOK, 1024, XP.G, XP.G - 1 - XP.bid);
                        pg8::EpiBf16S E{(bf16_t*)(XP.ws + WS_CAT), DM, XP.in[I_PS]};
                        pg8::gemm_phase(lds3, g, S, E, XP.tid);
                    }
                    if (P.pid + 1 < P.hi) { const Ctx XB = relaunder(X); xcd_barrier(P.bar, XB.tid == 0); } } ++P.pid;
                    PH_BEGIN {
                        pg8::Gemm g{(const bf16_t*)(XP.ws + WS_CAT), (const bf16_t*)(XP.ws + WS_WMO), MTOK, 2 * DM, DM / 2, DM, DM, 0, DM / 256, (size_t)DM};
                        pg8::MixedOrder S; S.init(XP.G, XP.bid);
                        pg8::EpiBf16Part E{YB16, DM, (size_t)MTOK * DM, DM / 256};
                        pg8::gemm_phase(lds3, g, S, E, XP.tid);
                    } PH_END
                } else {
                    PH_BEGIN {
                        pg8::Gemm g{U, (const bf16_t*)(XP.ws + WS_WSI), MTOK, SSMIN_PAD, DM, DM, DM, 0, SSMIN_PAD / 256, 0};
                        pg8::StaticOrder S; S.init(MTOK, SSMIN_PAD, XP.G, XP.bid);
                        pg8::EpiSsmIn E{(bf16_t*)(XP.ws + WS_ZXB), (float*)(XP.ws + WS_DT)};
                        pg8::gemm_phase(lds3, g, S, E, XP.tid);
                        conv_tail(XP, (MTOK / 256) * (SSMIN_PAD / 256), CVQ4, CVQ5);
                    } PH_END
                    PH_BEGIN ph_conv(X); PH_END
                    PH_BEGIN ph_ssd(X); PH_END
                    PH_BEGIN ph_gatenorm(X); PH_END
                    PH_BEGIN {
                        pg8::Gemm g{HID, (const bf16_t*)(XP.ws + WS_WSO), MTOK, 2 * DM, DINNER / 2, DINNER, DINNER, 0, DM / 256, (size_t)DINNER};
                        pg8::MixedOrder S; S.init(XP.G, XP.bid);
                        pg8::EpiBf16Part E{YB16, DM, (size_t)MTOK * DM, DM / 256};
                        pg8::gemm_phase(lds3, g, S, E, XP.tid);
                    } PH_END
                }
                PH_BEGIN ph_row<true, true, false, false>(X, nullptr, nullptr, nullptr, H, Y, 1.0f, mods + 5 * DM, ng + 3 * DM, mods + 6 * DM, mods + 7 * DM, ng + 4 * DM, U); PH_END
            } else {
                if constexpr (L == 0) {
                    PH_BEGIN ph_row<true, true, false, false>(X, nullptr, nullptr, nullptr, H, Y, 0.5f, mods + 8 * DM, ng + 5 * DM,
                                                MODS + (size_t)9 * NMODS + 0 * DM, MODS + (size_t)9 * NMODS + 1 * DM, NG + (size_t)6 * DM, U); PH_END
                } else {
                    PH_BEGIN ph_row<true, false, false, true>(X, nullptr, nullptr, X.out, H, Y, 0.5f, mods + 8 * DM, ng + 5 * DM, nullptr, nullptr, nullptr, nullptr); PH_END
                }
            }
}

__global__ void __launch_bounds__(NTHREADS, 2) fwd_kernel(Args args) {
    extern __shared__ __attribute__((aligned(16))) unsigned char lds[];
    Ctx X;
    X.tid = threadIdx.x; X.lane = X.tid & 63; X.wave = __builtin_amdgcn_readfirstlane(X.tid >> 6);
    X.G = gridDim.x; X.bid = blockIdx.x; X.gw = blockIdx.x * NWAVES + X.wave; X.NGW = X.G * NWAVES;
    X.ws = args.ws; X.in = (KinPtr)__builtin_amdgcn_kernarg_segment_ptr(); X.out = args.out; X.lds = lds;
    LAS unsigned char* lds3 = (LAS unsigned char*)lds;
    for (int u = X.tid; u < (LDS_BYTES - LDSCTL_OFF) / 4; u += NTHREADS) ((LAS unsigned*)(lds3 + LDSCTL_OFF))[u] = 0u;
    __syncthreads();
    const int lo = args.ph_lo, hi = args.ph_hi;
    const bool use_bar = (hi - lo) > 1;
    XcdBarrier bar; bar.bar = (unsigned*)(X.ws + WS_CTL) + CW_BAR; bar.x = 0; bar.st = nullptr;
    if (use_bar) bar = xcd_barrier_post((unsigned*)(X.ws + WS_CTL) + CW_BAR, (volatile LAS unsigned*)(lds3 + LDSCTL_OFF + 64));
    PhState P; P.pid = 0; P.lo = lo; P.hi = hi; P.bar = bar;

    float* MODS = (float*)(X.ws + WS_MODS);
    bf16_t* H = (bf16_t*)(X.ws + WS_H); bf16_t* YB16 = (bf16_t*)(X.ws + WS_Y); const bf16_t* Y = YB16; bf16_t* U = (bf16_t*)(X.ws + WS_U); bf16_t* HID = (bf16_t*)(X.ws + WS_HID);
    const float* NG = X.in[I_NG];

    PH_BEGIN ph_prologue(X); PH_END
    PH_BEGIN ph_row<false, true, true, false>(X, XP.in[I_XP], XP.in[I_XS], nullptr, nullptr, nullptr, 0.f, nullptr, nullptr, MODS + 0 * DM, MODS + 1 * DM, NG + 0 * DM, U); PH_END

    sub_layer<0, 0>(X, P); sub_layer<0, 1>(X, P); sub_layer<1, 0>(X, P); sub_layer<1, 1>(X, P);
#undef PH_BEGIN
#undef PH_END
}
constexpr int N_PHASES = 2 + (3 + 4 + 1 + 3) + (3 + 5 + 1 + 3);

extern "C" void kernel_launch(void* const* d_in, const int* in_sizes, int n_in, void* d_out, int out_size, void* d_ws, size_t ws_size, hipStream_t stream) {
    static int grid = 0;
    if (grid == 0) {
        if (n_in != 25 || out_size != OUT_TOTAL || ws_size < WS_END) { fprintf(stderr, "kernel_launch: unexpected shapes (n_in %d, out %d, ws %zu < %zu)\n", n_in, out_size, ws_size, (size_t)WS_END); grid = -1; return; }
        int dev = 0, cus = 0, per_cu = 0;
        if (hipGetDevice(&dev) != hipSuccess || hipDeviceGetAttribute(&cus, hipDeviceAttributeMultiprocessorCount, dev) != hipSuccess) { grid = -1; return; }
        if (hipFuncSetAttribute((const void*)fwd_kernel, hipFuncAttributeMaxDynamicSharedMemorySize, LDS_BYTES) != hipSuccess) { fprintf(stderr, "kernel_launch: hipFuncSetAttribute failed\n"); grid = -1; return; }
        if (hipOccupancyMaxActiveBlocksPerMultiprocessor(&per_cu, (const void*)fwd_kernel, NTHREADS, LDS_BYTES) != hipSuccess || per_cu < 1) { fprintf(stderr, "kernel_launch: occupancy query says %d\n", per_cu); }
        (void)hipGetLastError();
        grid = cus;
    }
    if (grid < 0) return;
    (void)hipMemsetAsync((char*)d_ws + WS_CTL, 0, CTL_ZERO_BYTES, stream);
    Args a{};
    for (int i = 0; i < 25; ++i) a.in[i] = (const float*)d_in[i];
    a.out = (float*)d_out; a.ws = (unsigned char*)d_ws;
#if MK_ONE_LAUNCH
    a.ph_lo = 0; a.ph_hi = N_PHASES;
    hipLaunchKernelGGL(fwd_kernel, dim3(grid), dim3(NTHREADS), LDS_BYTES, stream, a);
#else
    for (int p = 0; p < N_PHASES; ++p) { a.ph_lo = p; a.ph_hi = p + 1; hipLaunchKernelGGL(fwd_kernel, dim3(grid), dim3(NTHREADS), LDS_BYTES, stream, a); }
#endif
}
```

```cpp
#include <hip/hip_runtime.h>
#include <cstdio>
#include <cstdint>

#ifndef MK_ONE_LAUNCH
#define MK_ONE_LAUNCH 1
#endif

constexpr int DM = 2048, NP_TOK = 4096, NS_TOK = 8192, MTOK = 12288, DFF = 5632, NMODS = 9 * DM;
constexpr int MIXIN = 2560, DINNER = 4096, CONVD = 6144, SSMIN_PAD = 10496, ZXB_LD = 10240;
constexpr float EPS = 1e-6f;
constexpr int OUT_YP = 0, OUT_K = 25165824, OUT_V = 26214400, OUT_SSM = 27262976, OUT_TOTAL = 44040192;

constexpr size_t MiB = 1u << 20;
constexpr size_t WS_CTL = 0, CTL_ZERO_BYTES = 1 * MiB;
constexpr size_t WS_MODS = 1 * MiB;
constexpr size_t WS_ROPE = 2 * MiB + 512 * 1024;
constexpr size_t WS_W1T = 3 * MiB;
constexpr size_t WS_W2T = WS_W1T + 176 * MiB;
constexpr size_t WS_WMI = WS_W2T + 88 * MiB;
constexpr size_t WS_WMO = WS_WMI + 10 * MiB;
constexpr size_t WS_WSI = WS_WMO + 8 * MiB;
constexpr size_t WS_WSO = WS_WSI + 41 * MiB;
constexpr size_t WS_WPL = WS_WSO + 16 * MiB;
constexpr size_t WS_H = WS_WPL + 1 * MiB;
constexpr size_t WS_U = WS_H + 96 * MiB;
constexpr size_t WS_HID = WS_U + 48 * MiB;
constexpr size_t WS_Y = WS_HID + 132 * MiB;
constexpr size_t WS_MS = WS_Y + 96 * MiB;
constexpr size_t WS_P = WS_MS;
constexpr size_t WS_Q = WS_P + 120 * MiB;
constexpr size_t WS_KP = WS_Q + 24 * MiB;
constexpr size_t WS_VP = WS_KP + 2 * MiB;
constexpr size_t WS_KS = WS_VP + 2 * MiB;
constexpr size_t WS_VS = WS_KS + 6 * MiB;
constexpr size_t WS_D = WS_VS + 6 * MiB;
constexpr size_t WS_CAT = WS_D + 24 * MiB;
constexpr size_t WS_ZXB = WS_MS;
constexpr size_t WS_DT = WS_ZXB + 240 * MiB;
constexpr size_t WS_DTS = WS_DT + 6 * MiB;
constexpr size_t WS_XBC = WS_DTS + 6 * MiB;
constexpr size_t WS_YF = WS_XBC + 144 * MiB;
constexpr size_t WS_YB = WS_YF + 96 * MiB;
constexpr size_t WS_END = WS_YB + 96 * MiB;
static_assert(WS_CAT + 48 * MiB <= WS_END, "ws map");

constexpr int CW_BAR = 4096;

#define LAS __attribute__((address_space(3)))
#define GAS __attribute__((address_space(1)))
typedef unsigned short bf16_t;
typedef short bf16x8 __attribute__((ext_vector_type(8)));
typedef float f32x4 __attribute__((ext_vector_type(4)));
typedef unsigned u32x4 __attribute__((ext_vector_type(4)));
typedef unsigned u32x2 __attribute__((ext_vector_type(2)));

template <class T> __device__ __forceinline__ T ldg(const void* p) { return *(const GAS T*)p; }
template <class T> __device__ __forceinline__ void stg(void* p, T v) { *(GAS T*)p = v; }
typedef float f32x2n __attribute__((ext_vector_type(2)));
typedef __bf16 bf16x2n __attribute__((ext_vector_type(2)));
__device__ __forceinline__ unsigned pkbf(float lo, float hi) { return __builtin_bit_cast(unsigned, __builtin_convertvector((f32x2n){lo, hi}, bf16x2n)); }
__device__ __forceinline__ unsigned f2bf(float f) { return (unsigned)__builtin_bit_cast(unsigned short, (__bf16)f); }
__device__ __forceinline__ unsigned pk2(float lo, float hi) { return pkbf(lo, hi); }
__device__ __forceinline__ float bf2f(unsigned b) { return __builtin_bit_cast(float, b << 16); }
__device__ __forceinline__ float bflo(unsigned w) { return __builtin_bit_cast(float, w << 16); }
__device__ __forceinline__ float bfhi(unsigned w) { return __builtin_bit_cast(float, w & 0xffff0000u); }
__device__ __forceinline__ float lane_xor(float v, int lane, int o) { return __builtin_bit_cast(float, __builtin_amdgcn_ds_bpermute((lane ^ o) << 2, __builtin_bit_cast(int, v))); }
__device__ __forceinline__ float wave_sum(float v, int lane) {
#pragma unroll
    for (int o = 1; o < 64; o <<= 1) v += lane_xor(v, lane, o);
    return v;
}
__device__ __forceinline__ float silu_f(float x) { return x * __builtin_amdgcn_rcpf(1.0f + __expf(-x)); }

#define XB_TMO      128
#define XB_XCNT(j)  (256  + 64 * (j))
#define XB_XSUB(j)  (1280 + 64 * (j))
#define XB_XGEN(j)  (2304 + 64 * (j))
#define XB_TOP      3328
#define XB_TOPGEN   3392
#define XCD_BAR_WORDS 3456
#define XB_SPIN_CAP (1u << 18)
__device__ __forceinline__ unsigned xb_ld(unsigned* p)              { return __hip_atomic_load(p, __ATOMIC_RELAXED, __HIP_MEMORY_SCOPE_AGENT); }
__device__ __forceinline__ unsigned xb_add(unsigned* p, unsigned v) { return __hip_atomic_fetch_add(p, v, __ATOMIC_RELAXED, __HIP_MEMORY_SCOPE_AGENT); }
__device__ __forceinline__ unsigned xb_xcc_id() { return (unsigned)__builtin_amdgcn_s_getreg((3 << 11) | 20) & 0xFu; }
#define XB_SPIN(cond, bar) do { unsigned _sp = 0; while (cond) { __builtin_amdgcn_s_sleep(1); \
    if ((++_sp & 255u) == 0u) { if (xb_ld(&(bar)[XB_TMO])) break; if (_sp > XB_SPIN_CAP) { atomicAdd(&(bar)[XB_TMO], 1u); break; } } } } while (0)
struct XcdBarrier { unsigned* bar; unsigned x; volatile LAS unsigned* st; };
__device__ __forceinline__ XcdBarrier xcd_barrier_post(unsigned* bar, volatile LAS unsigned* st) {
    XcdBarrier b; b.bar = bar; b.x = xb_xcc_id(); b.st = st;
    if (threadIdx.x == 0) (void)xb_add(&bar[XB_XCNT(b.x)], 1u);
    return b;
}
__device__ __forceinline__ void xcd_barrier_complete(unsigned* bar, unsigned x, unsigned& nloc, unsigned& nx) {
    const unsigned G = gridDim.x * gridDim.y * gridDim.z;
    unsigned sum, cnt, mine, sp = 0u;
    for (;;) {
        sum = 0u; cnt = 0u; mine = 0u;
#pragma unroll
        for (unsigned j = 0; j < 16; ++j) { const unsigned c = xb_ld(&bar[XB_XCNT(j)]); sum += c; cnt += (c > 0u) ? 1u : 0u; mine = (j == x) ? c : mine; }
        if (sum == G) break;
        __builtin_amdgcn_s_sleep(1);
        if ((++sp & 255u) == 0u) { if (xb_ld(&bar[XB_TMO])) break; if (sp > XB_SPIN_CAP) { atomicAdd(&bar[XB_TMO], 1u); break; } }
    }
    nloc = mine > 0u ? mine : 1u; nx = cnt > 0u ? cnt : 1u;
}
__device__ __forceinline__ void xcd_barrier(const XcdBarrier& b, const bool leader) {
    asm volatile("s_waitcnt vmcnt(0)" ::: "memory");
    __syncthreads();
    if (leader) {
        unsigned* bar = b.bar; asm volatile("" : "+s"(bar));
        __builtin_amdgcn_s_waitcnt(0);
        unsigned nloc = b.st[0], nx = b.st[1];
        unsigned bx = b.x; asm volatile("" : "+s"(bx));
        if (nloc == 0u) { xcd_barrier_complete(bar, bx, nloc, nx); b.st[0] = nloc; b.st[1] = nx; }
        const unsigned old = xb_add(&bar[XB_XSUB(bx)], 1u);
        const unsigned gen = old / nloc;
        if (old + 1u == (gen + 1u) * nloc) {
            __builtin_amdgcn_fence(__ATOMIC_RELEASE, "agent");
            asm volatile("s_waitcnt vmcnt(0)" ::: "memory");
            const unsigned og = xb_add(&bar[XB_TOP], 1u);
            const unsigned tg = og / nx;
            if (og + 1u == (tg + 1u) * nx) xb_add(&bar[XB_TOPGEN], 1u);
            else XB_SPIN(xb_ld(&bar[XB_TOPGEN]) == tg, bar);
            __builtin_amdgcn_fence(__ATOMIC_ACQUIRE, "agent");
            xb_add(&bar[XB_XGEN(bx)], 1u);
            asm volatile("s_waitcnt vmcnt(0)" ::: "memory");
        } else {
            XB_SPIN(xb_ld(&bar[XB_XGEN(bx)]) == gen, bar);
            __builtin_amdgcn_fence(__ATOMIC_ACQUIRE, "agent");
            asm volatile("s_waitcnt vmcnt(0)" ::: "memory");
        }
    }
    __syncthreads();
}

namespace pg8 {
constexpr int BM = 256, BK = 64, HALF = 128, HTB = HALF * BK * 2, STAGE_BYTES = 8 * HTB, NXCD = 8, WGM = 8;
__host__ __device__ __forceinline__ int lds_byte(int r, int c) { const int st = (r >> 4) * 2 + (c >> 5), rr = r & 15, cc = c & 31, ob = rr * 64 + cc * 2; return st * 1024 + (ob ^ (((ob >> 9) & 1) << 5)); }
__host__ __device__ __forceinline__ void stage_rc(int b, int& R, int& C) { const int st = b / 1024, sb = b % 1024, swz = sb ^ (((sb >> 9) & 1) << 5); R = (st >> 1) * 16 + swz / 64; C = (st & 1) * 32 + (swz % 64) / 2; }
__host__ __device__ __forceinline__ int perm32(int rho) { const int n = rho >> 4, i = rho & 15; return 8 * (i >> 2) + 4 * n + (i & 3); }
struct Unit { int pm, pn, full; };
struct Gemm { const bf16_t* A; const bf16_t* Bt; int M, N, K, lda, ldb; size_t a_pn_step; int nNr; size_t ksb; };
struct StaticOrder {
    int nM, nN, nwg, G, c;
    __host__ __device__ void init(int M, int N, int G_, int c_) { nM = M / BM; nN = N / BM; nwg = nM * nN; G = G_; c = c_; }
    __host__ __device__ bool at(long L, Unit& u) const {
        if (L >= nwg) return false;
        int wgid = (int)L; { const int q = nwg / NXCD, r = nwg % NXCD, xcd = wgid % NXCD, off = wgid / NXCD; wgid = (xcd < r ? xcd * (q + 1) : r * (q + 1) + (xcd - r) * q) + off; }
        const int nig = WGM * nN, gid = wgid / nig, fm = gid * WGM, gsz = (nM - fm) < WGM ? (nM - fm) : WGM;
        u.pm = fm + ((wgid % nig) % gsz); u.pn = (wgid % nig) / gsz; u.full = 0; return true;
    }
    __host__ __device__ bool next(int i, Unit& u) const { return at((long)i * G + c, u); }
};
struct MixedOrder {
    StaticOrder a, b; int G, c;
    __host__ __device__ void init(int G_, int c_) { a.init(8192, 2048, G_, c_); b.init(4096, 4096, G_, c_); G = G_; c = c_; }
    __host__ __device__ bool next(int i, Unit& u) const {
        const long L = (long)i * G + c;
        if (L < 256) { const bool r = b.at(L, u); u.pm += 32; return r; }
        const bool r = a.at(L - 256, u); u.full = 1; return r;
    }
};
__device__ __forceinline__ unsigned cvt_pk_bf16(float lo, float hi) { return pkbf(lo, hi); }

struct EpiF32 {
    static constexpr bool PERM = false;
    float* C; int ldc;
    __device__ __forceinline__ void operator()(const f32x4 (&acc)[2][2][4][2], const Unit& u, int wr, int wc, int fr, int fq) const {
        const int row0 = u.pm * BM + wr * 64 + fr, col0 = u.pn * BM + wc * 32 + 4 * fq;
#pragma unroll
        for (int ai = 0; ai < 2; ++ai)
#pragma unroll
            for (int m = 0; m < 4; ++m) { float* rowp = C + (size_t)(row0 + ai * HALF + m * 16) * ldc + col0;
#pragma unroll
                for (int bj = 0; bj < 2; ++bj)
#pragma unroll
                    for (int n = 0; n < 2; ++n) stg<f32x4>(rowp + bj * HALF + n * 16, acc[ai][bj][m][n]); }
    }
};
struct EpiSwiGLU {
    static constexpr bool PERM = true;
    bf16_t* O; int ldc;
    __device__ __forceinline__ void operator()(const f32x4 (&acc)[2][2][4][2], const Unit& u, int wr, int wc, int fr, int fq) const {
        const int row0 = u.pm * BM + wr * 64 + fr, col0 = u.pn * HALF + wc * 32 + 8 * fq;
#pragma unroll
        for (int ai = 0; ai < 2; ++ai)
#pragma unroll
            for (int m = 0; m < 4; ++m) { bf16_t* rowp = O + (size_t)(row0 + ai * HALF + m * 16) * ldc + col0;
                float v[8];
#pragma unroll
                for (int n = 0; n < 2; ++n)
#pragma unroll
                    for (int i = 0; i < 4; ++i) { const float a = acc[ai][0][m][n][i], b = acc[ai][1][m][n][i]; v[n * 4 + i] = a * __builtin_amdgcn_rcpf(1.0f + __expf(-a)) * b; }
                u32x4 w; w.x = cvt_pk_bf16(v[0], v[1]); w.y = cvt_pk_bf16(v[2], v[3]); w.z = cvt_pk_bf16(v[4], v[5]); w.w = cvt_pk_bf16(v[6], v[7]);
                stg<u32x4>(rowp, w); }
    }
};
struct EpiBf16S {
    static constexpr bool PERM = true;
    bf16_t* O; int ldc; const float* scale;
    __device__ __forceinline__ void operator()(const f32x4 (&acc)[2][2][4][2], const Unit& u, int wr, int wc, int fr, int fq) const {
        const int row0 = u.pm * BM + wr * 64 + fr, col0 = u.pn * BM + wc * 32 + 8 * fq;
        f32x4 sv[2][2];
#pragma unroll
        for (int bj = 0; bj < 2; ++bj)
#pragma unroll
            for (int n = 0; n < 2; ++n) sv[bj][n] = scale ? ldg<f32x4>(scale + col0 + bj * HALF + 4 * n) : (f32x4){1.f, 1.f, 1.f, 1.f};
#pragma unroll
        for (int ai = 0; ai < 2; ++ai)
#pragma unroll
            for (int m = 0; m < 4; ++m) { bf16_t* rowp = O + (size_t)(row0 + ai * HALF + m * 16) * ldc + col0;
#pragma unroll
                for (int bj = 0; bj < 2; ++bj) { const f32x4 v0 = acc[ai][bj][m][0] * sv[bj][0], v1 = acc[ai][bj][m][1] * sv[bj][1];
                    u32x4 w; w.x = cvt_pk_bf16(v0[0], v0[1]); w.y = cvt_pk_bf16(v0[2], v0[3]); w.z = cvt_pk_bf16(v1[0], v1[1]); w.w = cvt_pk_bf16(v1[2], v1[3]);
                    stg<u32x4>(rowp + bj * HALF, w); } }
    }
};
struct EpiBf16Part {
    static constexpr bool PERM = true;
    bf16_t* O; int ldc; size_t plane; int nNr;
    __device__ __forceinline__ void operator()(const f32x4 (&acc)[2][2][4][2], const Unit& u, int wr, int wc, int fr, int fq) const {
        const int kh = u.pn / nNr, pnr = u.pn - kh * nNr;
        const int row0 = u.pm * BM + wr * 64 + fr, col0 = pnr * BM + wc * 32 + 8 * fq; bf16_t* base = O + (size_t)kh * plane;
#pragma unroll
        for (int ai = 0; ai < 2; ++ai)
#pragma unroll
            for (int m = 0; m < 4; ++m) { bf16_t* rowp = base + (size_t)(row0 + ai * HALF + m * 16) * ldc + col0;
#pragma unroll
                for (int bj = 0; bj < 2; ++bj) { const f32x4 v0 = acc[ai][bj][m][0], v1 = acc[ai][bj][m][1];
                    u32x4 w; w.x = cvt_pk_bf16(v0[0], v0[1]); w.y = cvt_pk_bf16(v0[2], v0[3]); w.z = cvt_pk_bf16(v1[0], v1[1]); w.w = cvt_pk_bf16(v1[2], v1[3]);
                    stg<u32x4>(rowp + bj * HALF, w); } }
    }
};
struct EpiSsmIn {
    static constexpr bool PERM = true;
    bf16_t* Z; float* DT;
    __device__ __forceinline__ void operator()(const f32x4 (&acc)[2][2][4][2], const Unit& u, int wr, int wc, int fr, int fq) const {
        const int row0 = u.pm * BM + wr * 64 + fr;
        if (u.pn < 40) {
            const int col0 = u.pn * BM + wc * 32 + 8 * fq;
#pragma unroll
            for (int ai = 0; ai < 2; ++ai)
#pragma unroll
                for (int m = 0; m < 4; ++m) { bf16_t* rowp = Z + (size_t)(row0 + ai * HALF + m * 16) * ZXB_LD + col0;
#pragma unroll
                    for (int bj = 0; bj < 2; ++bj) { const f32x4 v0 = acc[ai][bj][m][0], v1 = acc[ai][bj][m][1];
                        u32x4 w; w.x = cvt_pk_bf16(v0[0], v0[1]); w.y = cvt_pk_bf16(v0[2], v0[3]); w.z = cvt_pk_bf16(v1[0], v1[1]); w.w = cvt_pk_bf16(v1[2], v1[3]);
                        stg<u32x4>(rowp + bj * HALF, w); } }
        } else {
            const int col0 = wc * 32 + 8 * fq;
#pragma unroll
            for (int ai = 0; ai < 2; ++ai)
#pragma unroll
                for (int m = 0; m < 4; ++m) { float* rowp = DT + (size_t)(row0 + ai * HALF + m * 16) * 128 + col0;
                    stg<f32x4>(rowp, acc[ai][0][m][0]); stg<f32x4>(rowp + 4, acc[ai][0][m][1]); }
        }
    }
};

template <class Epi, class Sched>
__device__ __forceinline__ void gemm_phase(LAS unsigned char* lds, const Gemm g, const Sched& S, const Epi& E, const int tid) {
    const int wid = __builtin_amdgcn_readfirstlane(tid >> 6), lane = tid & 63, wr = wid >> 2, wc = wid & 3, fr = lane & 15, fq = lane >> 4;
    const int ntb = g.K / BK;
    unsigned voffA[2], voffB[2];
#pragma unroll
    for (int i = 0; i < 2; ++i) { int R, C; stage_rc(tid * 16 + i * 8192, R, C); const int Rb = Epi::PERM ? ((R & ~31) + perm32(R & 31)) : R;
        voffA[i] = (unsigned)(R * g.lda + C) * 2u; voffB[i] = (unsigned)(Rb * g.ldb + C) * 2u; }
    const size_t kstep = (size_t)(BK * 2);
    const size_t hstepA = (size_t)HALF * g.lda * 2, hstepB = (size_t)HALF * g.ldb * 2;
    const size_t tstepA = 2 * hstepA, tstepB = 2 * hstepB;
    const unsigned ldsw = (unsigned)wid * 1024u;
    const int aoff = lds_byte(wr * 64 + fr, fq * 8), boff = lds_byte(wc * 32 + fr, fq * 8);
#define PG8_SA(b, h) (((b) * 2 + (h)) * HTB)
#define PG8_SB(b, h) ((4 + (b) * 2 + (h)) * HTB)
#define PG8_STAGE(bufoff, gbase, voff) do { _Pragma("unroll") for (int _i = 0; _i < 2; ++_i) \
        __builtin_amdgcn_global_load_lds((const unsigned*)((const char*)(gbase) + (voff)[_i]), (LAS unsigned*)(lds + (bufoff) + ldsw + _i * 8192), 16, 0, 0); } while (0)
#define PG8_LDA(dst, b, h) do { _Pragma("unroll") for (int m = 0; m < 4; ++m) _Pragma("unroll") for (int k = 0; k < 2; ++k) dst[m][k] = *(const LAS bf16x8*)(lds + PG8_SA(b, h) + aoff + m * 2048 + k * 1024); } while (0)
#define PG8_LDB(dst, b, h) do { _Pragma("unroll") for (int n = 0; n < 2; ++n) _Pragma("unroll") for (int k = 0; k < 2; ++k) dst[n][k] = *(const LAS bf16x8*)(lds + PG8_SB(b, h) + boff + n * 2048 + k * 1024); } while (0)
#define PG8_MMA(ai, bj, At, Bt) do { __builtin_amdgcn_s_setprio(1); _Pragma("unroll") for (int m = 0; m < 4; ++m) _Pragma("unroll") for (int n = 0; n < 2; ++n) _Pragma("unroll") for (int k = 0; k < 2; ++k) \
        acc[ai][bj][m][n] = __builtin_amdgcn_mfma_f32_16x16x32_bf16(Bt[n][k], At[m][k], acc[ai][bj][m][n], 0, 0, 0); __builtin_amdgcn_s_setprio(0); } while (0)
#define PG8_WAIT_V(n) asm volatile("s_waitcnt vmcnt(" #n ")" ::: "memory")
#define PG8_WAIT_L(n) asm volatile("s_waitcnt lgkmcnt(" #n ")" ::: "memory")
#define PG8_BAR __builtin_amdgcn_s_barrier()
#define PG8_SCHED __builtin_amdgcn_sched_barrier(0)
    Unit cur, nxt; int ui = 0;
    if (!S.next(0, cur)) return;
    f32x4 acc[2][2][4][2];
#pragma unroll
    for (int a = 0; a < 2; ++a)
#pragma unroll
        for (int b = 0; b < 2; ++b)
#pragma unroll
            for (int m = 0; m < 4; ++m)
#pragma unroll
                for (int n = 0; n < 2; ++n) acc[a][b][m][n] = (f32x4){0.f, 0.f, 0.f, 0.f};
    bf16x8 At[4][2], B0[2][2], B1[2][2];
    const char* cA; const char* cB;
    { const int kh = cur.pn / g.nNr, pnr = cur.pn - kh * g.nNr;
      cA = (const char*)g.A + (size_t)cur.pm * tstepA + (size_t)pnr * g.a_pn_step + (size_t)kh * g.ksb; cB = (const char*)g.Bt + (size_t)pnr * tstepB + (size_t)kh * g.ksb; }
    PG8_STAGE(PG8_SB(0, 0), cB, voffB); PG8_STAGE(PG8_SB(0, 1), cB + hstepB, voffB); PG8_STAGE(PG8_SA(0, 0), cA, voffA); PG8_STAGE(PG8_SA(0, 1), cA + hstepA, voffA);
    if (wr == 1) PG8_BAR;
    PG8_WAIT_V(2); PG8_BAR;
    PG8_STAGE(PG8_SB(1, 0), cB + kstep, voffB); PG8_STAGE(PG8_SA(1, 0), cA + kstep, voffA); PG8_STAGE(PG8_SB(1, 1), cB + hstepB + kstep, voffB);
    PG8_WAIT_V(6); PG8_BAR;
    for (;;) {
        const bool has_next = S.next(ui + 1, nxt);
        const int nt = cur.full ? 2 * ntb : ntb;
        const char* nA = cA; const char* nB = cB;
        if (has_next) { const int kh = nxt.pn / g.nNr, pnr = nxt.pn - kh * g.nNr;
            nA = (const char*)g.A + (size_t)nxt.pm * tstepA + (size_t)pnr * g.a_pn_step + (size_t)kh * g.ksb; nB = (const char*)g.Bt + (size_t)pnr * tstepB + (size_t)kh * g.ksb; }
        for (int t = 0; t < nt; t += 2) {
            const bool last = (t == nt - 2);
            const char* a1 = cA + (size_t)(t + 1) * kstep;
            const char* a2 = last ? nA : cA + (size_t)(t + 2) * kstep; const char* b2 = last ? nB : cB + (size_t)(t + 2) * kstep;
            const char* a3 = a2 + kstep; const char* b3 = b2 + kstep;
            PG8_LDB(B0, 0, 0); PG8_LDB(B1, 0, 1); PG8_SCHED; PG8_LDA(At, 0, 0); PG8_STAGE(PG8_SA(1, 1), a1 + hstepA, voffA);
            PG8_WAIT_V(8); PG8_WAIT_L(0); PG8_BAR; PG8_MMA(0, 0, At, B0); PG8_MMA(0, 1, At, B1); PG8_BAR; PG8_SCHED;
            PG8_LDA(At, 0, 1); PG8_STAGE(PG8_SB(0, 0), b2, voffB); PG8_STAGE(PG8_SB(0, 1), b2 + hstepB, voffB); PG8_STAGE(PG8_SA(0, 0), a2, voffA);
            PG8_WAIT_V(8); PG8_WAIT_L(0); PG8_BAR; PG8_MMA(1, 0, At, B0); PG8_MMA(1, 1, At, B1); PG8_BAR; PG8_SCHED;
            PG8_LDB(B0, 1, 0); PG8_LDB(B1, 1, 1); PG8_SCHED; PG8_LDA(At, 1, 0); PG8_STAGE(PG8_SA(0, 1), a2 + hstepA, voffA);
            PG8_WAIT_V(8); PG8_WAIT_L(0); PG8_BAR; PG8_MMA(0, 0, At, B0); PG8_MMA(0, 1, At, B1); PG8_BAR; PG8_SCHED;
            PG8_LDA(At, 1, 1); PG8_STAGE(PG8_SB(1, 0), b3, voffB); PG8_STAGE(PG8_SB(1, 1), b3 + hstepB, voffB); PG8_STAGE(PG8_SA(1, 0), a3, voffA);
            PG8_WAIT_V(8); PG8_WAIT_L(0); PG8_BAR; PG8_MMA(1, 0, At, B0); PG8_MMA(1, 1, At, B1); PG8_BAR; PG8_SCHED;
        }
        if (wr == 0) PG8_BAR;
        E(acc, cur, wr, wc, fr, fq);
        if (!has_next) break;
#pragma unroll
        for (int a = 0; a < 2; ++a)
#pragma unroll
            for (int b = 0; b < 2; ++b)
#pragma unroll
                for (int m = 0; m < 4; ++m)
#pragma unroll
                    for (int n = 0; n < 2; ++n) acc[a][b][m][n] = (f32x4){0.f, 0.f, 0.f, 0.f};
        cur = nxt; cA = nA; cB = nB; ++ui;
        if (wr == 1) PG8_BAR;
    }
    PG8_WAIT_V(0);
    PG8_BAR;
#undef PG8_SA
#undef PG8_SB
#undef PG8_STAGE
#undef PG8_LDA
#undef PG8_LDB
#undef PG8_MMA
#undef PG8_WAIT_V
#undef PG8_WAIT_L
#undef PG8_BAR
#undef PG8_SCHED
}
}

namespace att {
constexpr int D = 128, NW = 8, QBLK = 32, KVBLK = 64;
constexpr float SCALE = 0.088388347648318440f;
constexpr float THR = 8.f;
constexpr size_t SHM_V = KVBLK * D * 2, SHM_K = KVBLK * D * 2, SHM_ATTN = 2 * SHM_V + 2 * SHM_K + NW * 64 * 4;
using s16x4  = __attribute__((ext_vector_type(4))) short;
using f32x16 = __attribute__((ext_vector_type(16))) float;
#define KSWZ(row, colB) ((row) * 256 + ((colB) ^ (((row) & 7) << 4)))
#define SBAR() __builtin_amdgcn_sched_barrier(0)
__device__ __forceinline__ int crow(int r, int hi) { return (r & 3) + 8 * (r >> 2) + 4 * hi; }
__device__ __forceinline__ unsigned cvtpk(float lo, float hi) { return pkbf(lo, hi); }
__device__ __forceinline__ void partialSM(f32x16& p0, f32x16& p1, float& m_reg, float& mn, float& alpha) {
  constexpr float C = SCALE * 1.4426950408889634f;
  float pmax = p0[0]; for (int r = 1; r < 16; ++r) pmax = fmaxf(pmax, p0[r]); for (int r = 0; r < 16; ++r) pmax = fmaxf(pmax, p1[r]);
  { auto rr = __builtin_amdgcn_permlane32_swap(__float_as_uint(pmax), __float_as_uint(pmax), false, false);
    pmax = fmaxf(__uint_as_float(rr[0]), __uint_as_float(rr[1])); }
  if (__builtin_expect(__all(pmax - m_reg <= THR / SCALE), 1)) { mn = m_reg; alpha = 1.f; }
  else { mn = fmaxf(m_reg, pmax); alpha = __builtin_amdgcn_exp2f((m_reg - mn) * C); m_reg = mn; }
  float mnC = -mn * C;
  for (int r = 0; r < 16; ++r) p0[r] = fmaf(p0[r], C, mnC); for (int r = 0; r < 16; ++r) p1[r] = fmaf(p1[r], C, mnC);
  for (int r = 0; r < 16; ++r) p0[r] = __builtin_amdgcn_exp2f(p0[r]);
}
__device__ __forceinline__ void finishSM(f32x16& p0, f32x16& p1, float alpha, float& l_reg, bf16x8& pa0, bf16x8& pa1, bf16x8& pa2, bf16x8& pa3) {
  for (int r = 0; r < 16; ++r) p1[r] = __builtin_amdgcn_exp2f(p1[r]);
  float ps = 0; for (int r = 0; r < 16; ++r) ps += p0[r]; for (int r = 0; r < 16; ++r) ps += p1[r];
  { auto rr = __builtin_amdgcn_permlane32_swap(__float_as_uint(ps), __float_as_uint(ps), false, false);
    ps = __uint_as_float(rr[0]) + __uint_as_float(rr[1]); }
  l_reg = l_reg * alpha + ps;
#define PK4(P, BASE, OUT) do { unsigned a0 = cvtpk(P[BASE + 0], P[BASE + 1]), a1 = cvtpk(P[BASE + 2], P[BASE + 3]);   \
    unsigned b0 = cvtpk(P[BASE + 4], P[BASE + 5]), b1 = cvtpk(P[BASE + 6], P[BASE + 7]);                              \
    auto r0 = __builtin_amdgcn_permlane32_swap(a0, b0, false, false); auto r1 = __builtin_amdgcn_permlane32_swap(a1, b1, false, false); \
    u32x4 w = {r0[0], r1[0], r0[1], r1[1]}; OUT = *reinterpret_cast<bf16x8*>(&w); } while (0)
  PK4(p0, 0, pa0); PK4(p0, 8, pa1); PK4(p1, 0, pa2); PK4(p1, 8, pa3);
#undef PK4
}
__device__ __forceinline__ void qkt(f32x16& p0, f32x16& p1, const LAS char* Ks, const bf16x8* qr, int r32, int hi) {
  p0 = f32x16{}; p1 = f32x16{};
  for (int d0 = 0; d0 < 8; ++d0) { int cb = (d0 * 16 + hi * 8) * 2;
    bf16x8 b0 = *(const LAS bf16x8*)(Ks + KSWZ(r32, cb));
    bf16x8 b1 = *(const LAS bf16x8*)(Ks + KSWZ(32 + r32, cb));
    p0 = __builtin_amdgcn_mfma_f32_32x32x16_bf16(b0, qr[d0], p0, 0, 0, 0);
    p1 = __builtin_amdgcn_mfma_f32_32x32x16_bf16(b1, qr[d0], p1, 0, 0, 0); }
}
__device__ __forceinline__ int v_st(int k, int c) { const int kk = (k & ~0xC) | ((k & 4) << 1) | ((k & 8) >> 1); return ((kk >> 3) * 4 + (c >> 5)) * 512 + ((kk & 7) * 32 + (c & 31)) * 2; }
__device__ __forceinline__ int v_rd_base(int lane) { return ((lane & 3) << 3) | (((lane >> 2) & 3) << 6) | (((lane >> 4) & 1) << 5) | (((lane >> 5) & 1) << 8); }
constexpr int v_rd_off(int d0, int ks, int half) { return d0 * 512 + ks * 4096 + half * 2048; }
template <int OFF> __device__ __forceinline__ s16x4 tr_read(int vb) {
  s16x4 r; asm volatile("ds_read_b64_tr_b16 %0, %1 offset:%2" : "=&v"(r) : "v"(vb), "i"(OFF) : "memory"); return r;
}
template <int D0> __device__ __forceinline__ void pv_one(f32x16& od, int vb, bf16x8 pa0, bf16x8 pa1, bf16x8 pa2, bf16x8 pa3) {
  const s16x4 l0 = tr_read<v_rd_off(D0, 0, 0)>(vb), h0 = tr_read<v_rd_off(D0, 0, 1)>(vb), l1 = tr_read<v_rd_off(D0, 1, 0)>(vb), h1 = tr_read<v_rd_off(D0, 1, 1)>(vb);
  const s16x4 l2 = tr_read<v_rd_off(D0, 2, 0)>(vb), h2 = tr_read<v_rd_off(D0, 2, 1)>(vb), l3 = tr_read<v_rd_off(D0, 3, 0)>(vb), h3 = tr_read<v_rd_off(D0, 3, 1)>(vb);
  asm volatile("s_waitcnt lgkmcnt(0)" ::: "memory"); SBAR();
#define PK(L, H) (bf16x8){L[0], L[1], L[2], L[3], H[0], H[1], H[2], H[3]}
  od = __builtin_amdgcn_mfma_f32_32x32x16_bf16(pa0, PK(l0, h0), od, 0, 0, 0);
  od = __builtin_amdgcn_mfma_f32_32x32x16_bf16(pa1, PK(l1, h1), od, 0, 0, 0);
  od = __builtin_amdgcn_mfma_f32_32x32x16_bf16(pa2, PK(l2, h2), od, 0, 0, 0);
  od = __builtin_amdgcn_mfma_f32_32x32x16_bf16(pa3, PK(l3, h3), od, 0, 0, 0);
#undef PK
}
__device__ __forceinline__ void pv_d0(f32x16* o, int vb, bf16x8 pa0, bf16x8 pa1, bf16x8 pa2, bf16x8 pa3) {
  pv_one<0>(o[0], vb, pa0, pa1, pa2, pa3); pv_one<1>(o[1], vb, pa0, pa1, pa2, pa3); pv_one<2>(o[2], vb, pa0, pa1, pa2, pa3); pv_one<3>(o[3], vb, pa0, pa1, pa2, pa3);
}
template <int LDQ, int LDK, int LDO>
__device__ __forceinline__ void attn_body(const bf16_t* __restrict__ Qb, const bf16_t* __restrict__ Kh, const bf16_t* __restrict__ Vh, bf16_t* __restrict__ Ob, int seq, LAS char* lds, const int tid) {
  const int wid = tid >> 6, lane = tid & 63, r32 = lane & 31, hi = lane >> 5;
  LAS char* V_lds = lds; LAS char* K_lds = lds + 2 * SHM_V;
  LAS float* ws = (LAS float*)(lds + 2 * SHM_V + 2 * SHM_K) + wid * 64; LAS float* li_l = ws; LAS float* al_l = ws + 32;
  float m_reg = -1e30f, l_reg = 0; f32x16 o[4] = {}; bf16x8 qr[8];
  const bf16_t* Qw = Qb + (long)(wid * QBLK + r32) * LDQ + hi * 8;
#pragma unroll
  for (int d0 = 0; d0 < 8; ++d0) qr[d0] = ldg<bf16x8>(Qw + d0 * 16);
  const int sr = tid >> 4, sc = (tid & 15) * 8, vst0 = v_st(sr, sc), vst1 = v_st(32 + sr, sc);
  const int vb0 = (int)(unsigned)(uintptr_t)V_lds + v_rd_base(lane);
  struct { bf16x8 vs0, vs1, ks0, ks1; } sr_[1];
  const unsigned kvoff = (unsigned)(sr * LDK + sc) * 2u;
#define SLOAD(i, k0) do { const char* vt_ = (const char*)(Vh + (long)(k0) * LDK); const char* kt_ = (const char*)(Kh + (long)(k0) * LDK); \
    sr_[i].vs0 = ldg<bf16x8>(vt_ + kvoff); sr_[i].vs1 = ldg<bf16x8>(vt_ + 32 * LDK * 2 + kvoff); \
    sr_[i].ks0 = ldg<bf16x8>(kt_ + kvoff); sr_[i].ks1 = ldg<bf16x8>(kt_ + 32 * LDK * 2 + kvoff); } while (0)
#define SWRITE(b, i) do { *(LAS bf16x8*)(V_lds + (b) * SHM_V + vst0) = sr_[i].vs0;          \
    *(LAS bf16x8*)(V_lds + (b) * SHM_V + vst1) = sr_[i].vs1; int kc = sc * 2;               \
    *(LAS bf16x8*)(K_lds + (b) * SHM_K + KSWZ(sr, kc)) = sr_[i].ks0;                       \
    *(LAS bf16x8*)(K_lds + (b) * SHM_K + KSWZ(32 + sr, kc)) = sr_[i].ks1; } while (0)
#define SWAIT() asm volatile("s_waitcnt vmcnt(0)" ::: "memory")
#define RESC(a) do { if (__any((a) < 1.f)) { if (hi == 0) al_l[r32] = (a); asm volatile("s_waitcnt lgkmcnt(0)" ::: "memory"); \
    for (int d = 0; d < 4; ++d) for (int r = 0; r < 16; ++r) o[d][r] *= al_l[crow(r, hi)]; } } while (0)
  f32x16 pA0, pA1, pB0, pB1; float mnA, mnB, alA, alB; bf16x8 pa0, pa1, pa2, pa3; const int NT = seq / KVBLK;
  constexpr int SE = 0, SO = 0;
  SLOAD(SE, 0); asm volatile("s_waitcnt vmcnt(0)" ::: "memory"); SWRITE(0, SE); __syncthreads();
  qkt(pA0, pA1, K_lds, qr, r32, hi); partialSM(pA0, pA1, m_reg, mnA, alA);
  SLOAD(SO, KVBLK);
  SWAIT(); SWRITE(1, SO); __syncthreads();
  for (int j = 1; j + 1 < NT; j += 2) {
    SBAR(); qkt(pB0, pB1, K_lds + SHM_K, qr, r32, hi);
    finishSM(pA0, pA1, alA, l_reg, pa0, pa1, pa2, pa3); SBAR();
    SLOAD(SO, (j + 1) * KVBLK); SBAR();
    pv_d0(o, vb0, pa0, pa1, pa2, pa3); partialSM(pB0, pB1, m_reg, mnB, alB);
    __syncthreads(); SWAIT(); SWRITE(0, SE);
    RESC(alB); __syncthreads();
    SBAR(); qkt(pA0, pA1, K_lds, qr, r32, hi);
    finishSM(pB0, pB1, alB, l_reg, pa0, pa1, pa2, pa3); SBAR();
    SLOAD(SE, (j + 2) * KVBLK); SBAR();
    pv_d0(o, vb0 + (int)SHM_V, pa0, pa1, pa2, pa3); partialSM(pA0, pA1, m_reg, mnA, alA);
    __syncthreads(); SWAIT(); SWRITE(1, SO);
    RESC(alA); __syncthreads();
  }
  SBAR(); qkt(pB0, pB1, K_lds + SHM_K, qr, r32, hi);
  finishSM(pA0, pA1, alA, l_reg, pa0, pa1, pa2, pa3); SBAR();
  pv_d0(o, vb0, pa0, pa1, pa2, pa3); partialSM(pB0, pB1, m_reg, mnB, alB);
  __syncthreads(); RESC(alB);
  finishSM(pB0, pB1, alB, l_reg, pa0, pa1, pa2, pa3); SBAR();
  pv_d0(o, vb0 + (int)SHM_V, pa0, pa1, pa2, pa3);
  if (hi == 0) li_l[r32] = l_reg; asm volatile("s_waitcnt lgkmcnt(0)" ::: "memory");
  float rli[16];
#pragma unroll
  for (int r = 0; r < 16; ++r) rli[r] = __builtin_amdgcn_rcpf(li_l[crow(r, hi)]);
  bf16_t* Ow = Ob + (long)(wid * QBLK) * LDO;
#pragma unroll
  for (int r = 0; r < 16; ++r) { int orow = crow(r, hi);
    for (int d0 = 0; d0 < 4; ++d0) stg<bf16_t>(Ow + (long)orow * LDO + d0 * 32 + r32, (bf16_t)f2bf(o[d0][r] * rli[r])); }
#undef SLOAD
#undef SWRITE
#undef SWAIT
#undef RESC
}
}

constexpr int NWAVES = 8, NTHREADS = 512;
constexpr int RING_BYTES = 131072, LDSCTL_OFF = RING_BYTES, LDS_BYTES = 147456;

struct Args { const float* in[25]; float* out; unsigned char* ws; int ph_lo, ph_hi; };
enum { I_XP = 0, I_XS, I_CK, I_CV, I_ST, I_C, I_CCTX, I_ADAW, I_ADAB, I_NG, I_FWI, I_FWO, I_MWI, I_PW, I_PS, I_QKG, I_MWO, I_SWI, I_CW, I_CB, I_DTB, I_ALOG, I_SD, I_SNG, I_SWO };

typedef const float* const __attribute__((address_space(4)))* KinPtr;
struct Ctx {
    int tid, lane, wave, G, gw, NGW, bid;
    unsigned char* ws; KinPtr in; float* out;
    unsigned char* lds;
};

__device__ __forceinline__ Ctx relaunder(const Ctx& X0) {
    Ctx X = X0; int wv = X0.wave; asm volatile("" : "+s"(wv)); int ln; asm volatile("v_mbcnt_lo_u32_b32 %0, -1, 0\n\tv_mbcnt_hi_u32_b32 %0, -1, %0" : "=v"(ln));
    int b = X0.bid; asm volatile("" : "+s"(b));
    unsigned char* w = X0.ws; asm volatile("" : "+s"(w)); X.ws = w;
    KinPtr ki = X0.in; asm volatile("" : "+s"(ki)); X.in = ki;
    X.tid = wv * 64 + ln; X.lane = ln; X.wave = wv; X.bid = b; X.gw = b * NWAVES + wv; return X;
}
struct CvJob { const float* src; bf16_t* dst; int N, ldt, r0, k0, n0; };
constexpr int CV_FI = 32 * 352, CV_FO = 88 * 64, CV_MI = 32 * 80, CV_MO = 32 * 64, CV_PL = 4 * 8, CV_SI = 32 * 324, CV_SO = 64 * 64;
constexpr int CV_E0 = CV_FI + CV_FO;
constexpr int CV_E1 = CV_E0 + CV_MI + CV_MO + 4 * CV_PL;
constexpr int CV_E2 = CV_E1 + CV_FI + CV_FO;
constexpr int CV_E3 = CV_E2 + CV_FI + CV_FO;
constexpr int CV_E4 = CV_E3 + CV_SI + CV_SO;
constexpr int CV_E5 = CV_E4 + CV_FI;
constexpr int CV_TOTAL = CV_E5 + CV_FO;
__device__ __forceinline__ CvJob cv_mat(const float* W, int K, int N, bf16_t* WT, int ldt, int mode, int item) {
    const int nblk = N / 32, kb = item / nblk, nb = item - kb * nblk, n0 = 32 * nb;
    int r0 = n0; if (mode == 1) r0 = (n0 < DFF) ? ((n0 >> 7) * 256 + (n0 & 127)) : ((((n0 - DFF) >> 7) * 256) + 128 + ((n0 - DFF) & 127));
    (void)K; return CvJob{W, WT, N, ldt, r0, 64 * kb, n0};
}
__device__ __forceinline__ CvJob cv_ffn(const Ctx& X, int w, int r) {
    if (r < CV_FI) return cv_mat(X.in[I_FWI] + (size_t)w * DM * 2 * DFF, DM, 2 * DFF, (bf16_t*)(X.ws + WS_W1T) + (size_t)w * 2 * DFF * DM, DM, 1, r);
    return cv_mat(X.in[I_FWO] + (size_t)w * DFF * DM, DFF, DM, (bf16_t*)(X.ws + WS_W2T) + (size_t)w * DM * DFF, DFF, 0, r - CV_FI);
}
__device__ __forceinline__ CvJob cv_job(const Ctx& X, int it) {
    if (it < CV_E0) return cv_ffn(X, 0, it);
    if (it < CV_E1) { int r = it - CV_E0;
        if (r < CV_MI) return cv_mat(X.in[I_MWI], DM, MIXIN, (bf16_t*)(X.ws + WS_WMI), DM, 0, r); r -= CV_MI;
        if (r < CV_MO) return cv_mat(X.in[I_MWO], DM, DM, (bf16_t*)(X.ws + WS_WMO), DM, 0, r); r -= CV_MO;
        const int gq = r / CV_PL; return cv_mat(X.in[I_PW] + (size_t)gq * 65536, 256, 256, (bf16_t*)(X.ws + WS_WPL) + (size_t)gq * 65536, 256, 0, r - gq * CV_PL); }
    if (it < CV_E2) return cv_ffn(X, 1, it - CV_E1);
    if (it < CV_E3) return cv_ffn(X, 2, it - CV_E2);
    if (it < CV_E4) { int r = it - CV_E3;
        if (r < CV_SI) return cv_mat(X.in[I_SWI], DM, 10368, (bf16_t*)(X.ws + WS_WSI), DM, 0, r);
        return cv_mat(X.in[I_SWO], DINNER, DM, (bf16_t*)(X.ws + WS_WSO), DINNER, 0, r - CV_SI); }
    if (it < CV_E5) return cv_mat(X.in[I_FWI] + (size_t)3 * DM * 2 * DFF, DM, 2 * DFF, (bf16_t*)(X.ws + WS_W1T) + (size_t)3 * 2 * DFF * DM, DM, 1, it - CV_E4);
    return cv_mat(X.in[I_FWO] + (size_t)3 * DFF * DM, DFF, DM, (bf16_t*)(X.ws + WS_W2T) + (size_t)3 * DM * DFF, DFF, 0, it - CV_E5);
}
__device__ __forceinline__ void cv_load(const CvJob& J, int lane, float (&v)[32]) {
    const float* wp = J.src + (size_t)(J.k0 + (lane >> 5)) * J.N + J.n0 + (lane & 31);
#pragma unroll
    for (int i = 0; i < 32; ++i) v[i] = ldg<float>(wp + (size_t)(2 * i) * J.N);
}
__device__ __forceinline__ void cv_emit(const CvJob& J, int lane, const float (&v)[32], LAS float* scr) {
#pragma unroll
    for (int i = 0; i < 32; ++i) scr[(2 * i + (lane >> 5)) * 33 + (lane & 31)] = v[i];
    asm volatile("s_waitcnt lgkmcnt(0)" ::: "memory");
    const int c = lane & 7;
#pragma unroll
    for (int j = 0; j < 4; ++j) { const int n = (lane >> 3) + 8 * j; const LAS float* sp = scr + (8 * c) * 33 + n;
        u32x4 o; o.x = pk2(sp[0 * 33], sp[1 * 33]); o.y = pk2(sp[2 * 33], sp[3 * 33]); o.z = pk2(sp[4 * 33], sp[5 * 33]); o.w = pk2(sp[6 * 33], sp[7 * 33]);
        stg<u32x4>(J.dst + (size_t)(J.r0 + n) * J.ldt + J.k0 + 8 * c, o); }
    asm volatile("s_waitcnt lgkmcnt(0)" ::: "memory");
}
__device__ __forceinline__ void conv_range(const Ctx& X, int lo, int hi, int slot, int nslots) {
    LAS float* scr = (LAS float*)((LAS unsigned char*)X.lds + X.wave * 16384);
    for (int it = lo + slot; it < hi; it += 2 * nslots) {
        const int it2 = it + nslots; const bool two = it2 < hi;
        const CvJob A = cv_job(X, it), B = cv_job(X, two ? it2 : it);
        float va[32], vb[32];
        cv_load(A, X.lane, va); if (two) cv_load(B, X.lane, vb);
        cv_emit(A, X.lane, va, scr); if (two) cv_emit(B, X.lane, vb, scr);
    }
}
constexpr int CVQ0 = 39936, CVQ1 = CVQ0 + 11520, CVQ2 = CVQ1 + 1856, CVQ3 = CVQ2 + 11520, CVQ4 = CVQ3 + 11520, CVQ5 = CVQ4 + 4800;
static_assert(CVQ0 >= CV_E1 && CVQ2 >= CV_E2 && CVQ3 >= CV_E3 && CVQ4 >= CV_E4 && CVQ5 >= CV_E5 && CVQ5 <= CV_TOTAL, "every weight copy is finished at least one grid barrier before its first use");
__device__ __forceinline__ void conv_tail(const Ctx& X, int nwg, int lo, int hi) {
    const int rem = nwg % X.G; if (X.bid < rem) return;
    conv_range(X, lo, hi, (X.bid - rem) * NWAVES + X.wave, (X.G - rem) * NWAVES);
}
__device__ __forceinline__ void ph_prologue(const Ctx& X0) {
    const Ctx X = relaunder(X0);
    LAS unsigned char* lds3 = (LAS unsigned char*)X.lds;
    {
        LAS float* sc = (LAS float*)lds3;
        LAS float* red = (LAS float*)lds3;
        for (int it = X.bid; it < 256; it += X.G) {
            for (int e = X.tid; e < 2048 * 9; e += NTHREADS) { const int k = e / 9, ci = e % 9;
                const float v = (ci == 0) ? X.in[I_CCTX][k] : X.in[I_C][(ci - 1) * DM + k]; sc[k * 12 + ci] = silu_f(v); }
            __syncthreads();
            const int l = it / 128, c0 = (it % 128) * 144;
            const int cg = X.tid % 36, kp = X.tid / 36;
            float acc[9][4];
#pragma unroll
            for (int ci = 0; ci < 9; ++ci)
#pragma unroll
                for (int j = 0; j < 4; ++j) acc[ci][j] = 0.f;
            if (kp < 14) {
                const int kbeg = kp * 147, kend = (kbeg + 147 < 2048) ? kbeg + 147 : 2048;
                const float* wp = X.in[I_ADAW] + (size_t)l * DM * NMODS + c0 + cg * 4;
#pragma unroll 4
                for (int k = kbeg; k < kend; ++k) {
                    const f32x4 w = ldg<f32x4>(wp + (size_t)k * NMODS);
                    const f32x4 s0 = *(const LAS f32x4*)(sc + k * 12), s1 = *(const LAS f32x4*)(sc + k * 12 + 4); const float s8 = sc[k * 12 + 8];
#pragma unroll
                    for (int j = 0; j < 4; ++j) {
                        acc[0][j] += s0[0] * w[j]; acc[1][j] += s0[1] * w[j]; acc[2][j] += s0[2] * w[j]; acc[3][j] += s0[3] * w[j];
                        acc[4][j] += s1[0] * w[j]; acc[5][j] += s1[1] * w[j]; acc[6][j] += s1[2] * w[j]; acc[7][j] += s1[3] * w[j]; acc[8][j] += s8 * w[j]; }
                }
            }
            __syncthreads();
            if (kp < 14) {
#pragma unroll
                for (int ci = 0; ci < 9; ++ci)
#pragma unroll
                    for (int j = 0; j < 4; ++j) red[(kp * 9 + ci) * 144 + cg * 4 + j] = acc[ci][j];
            }
            __syncthreads();
#pragma unroll
            for (int q = 0; q < 3; ++q) { const int o = X.tid + q * NTHREADS; if (o < 1296) { float s = 0.f; for (int pp = 0; pp < 14; ++pp) s += red[pp * 1296 + o];
                const int ci = o / 144, cc = o % 144;
                ((float*)(X.ws + WS_MODS))[((size_t)l * 9 + ci) * NMODS + c0 + cc] = s + X.in[I_ADAB][(size_t)l * NMODS + c0 + cc]; } }
            __syncthreads();
        }
    }
    if (X.bid == X.G - 1 && X.wave == 0 && X.lane < 32) {
        double f = 1.0; for (int i = 0; i < X.lane; ++i) f *= 0.74989420933245582730;
        double c1 = 1.0, s1 = f, term_c = 1.0, term_s = f;
        for (int n = 1; n < 14; ++n) { term_c *= -f * f / ((2.0 * n - 1.0) * (2.0 * n)); term_s *= -f * f / ((2.0 * n) * (2.0 * n + 1.0)); c1 += term_c; s1 += term_s; }
        double c = 1.0, s = 0.0; float* rc = (float*)(X.ws + WS_ROPE); float* rs = rc + 64 * 32;
        for (int pos = 0; pos < 64; ++pos) { rc[pos * 32 + X.lane] = (float)c; rs[pos * 32 + X.lane] = (float)s; const double cn = c * c1 - s * s1, sn = s * c1 + c * s1; c = cn; s = sn; }
    }
    {
        bf16_t* KS = (bf16_t*)(X.ws + WS_KS); bf16_t* VS = (bf16_t*)(X.ws + WS_VS);
        const int n4 = 8 * 512 * 2 * 128 / 4;
        for (int e = X.bid * NTHREADS + X.tid; e < 2 * n4; e += X.G * NTHREADS) {
            const int which = e / n4, q = e % n4, el = q * 4;
            const int d = el & 127, kvh = (el >> 7) & 1, s = (el >> 8) & 511, b = el >> 17;
            const f32x4 v = ldg<f32x4>((which ? X.in[I_CV] : X.in[I_CK]) + el);
            u32x2 w; w.x = pk2(v[0], v[1]); w.y = pk2(v[2], v[3]);
            stg<u32x2>((which ? VS : KS) + ((size_t)(b * 2 + kvh) * 1536 + s) * 128 + d, w);
        }
        u32x4* z = (u32x4*)(X.ws + WS_WSI + (size_t)10368 * DM * 2);
        for (int e = X.bid * NTHREADS + X.tid; e < 128 * DM * 2 / 16; e += X.G * NTHREADS) z[e] = (u32x4){0u, 0u, 0u, 0u};
    }
    conv_range(X, 0, CVQ0, X.gw, X.NGW);
}
template <bool HAS_RES, bool HAS_U, bool HIN_F32, bool HOUT_F32>
__device__ __forceinline__ void ph_row(const Ctx& X0, const float* hin_p, const float* hin_s, float* hout, bf16_t* Hb, const bf16_t* Y, float wres,
                                       const float* gate, const float* g_post, const float* shift, const float* scale, const float* g_pre, bf16_t* U) {
    const Ctx X = relaunder(X0);
    LAS float* Lg = (LAS float*)X.lds;
    for (int e = X.tid; e < DM / 4; e += NTHREADS) {
        if (HAS_RES) *(LAS f32x4*)(Lg + e * 4) = ldg<f32x4>(g_post + e * 4);
        if (HAS_U) *(LAS f32x4*)(Lg + DM + e * 4) = ldg<f32x4>(g_pre + e * 4); }
    int ci_cur = -1;
    const int rpw = (((MTOK + X.G - 1) / X.G) + 7) & ~7;
    const int mbeg = X.bid * rpw, mend = mbeg + rpw < MTOK ? mbeg + rpw : MTOK;
    for (int m0 = mbeg; m0 < mend; m0 += NWAVES) {
        const int m = m0 + X.wave;
        const int ci = m0 < NP_TOK ? 0 : 1 + ((m0 - NP_TOK) >> 10);
        if (ci != ci_cur) {
            __syncthreads();
            for (int e = X.tid; e < DM / 4; e += NTHREADS) {
                if (HAS_RES) *(LAS f32x4*)(Lg + 2 * DM + e * 4) = ldg<f32x4>(gate + (size_t)ci * NMODS + e * 4);
                if (HAS_U) { *(LAS f32x4*)(Lg + 3 * DM + e * 4) = ldg<f32x4>(shift + (size_t)ci * NMODS + e * 4); *(LAS f32x4*)(Lg + 4 * DM + e * 4) = ldg<f32x4>(scale + (size_t)ci * NMODS + e * 4); } }
            __syncthreads(); ci_cur = ci;
        }
        f32x4 h[8];
        if (HIN_F32) { const float* hrow = (m < NP_TOK) ? hin_p + (size_t)m * DM : hin_s + (size_t)(m - NP_TOK) * DM;
#pragma unroll
            for (int j = 0; j < 8; ++j) h[j] = ldg<f32x4>(hrow + j * 256 + X.lane * 4); }
        else {
#pragma unroll
            for (int j = 0; j < 8; ++j) { const u32x2 hp = ldg<u32x2>(Hb + (size_t)m * DM + j * 256 + X.lane * 4); h[j] = (f32x4){bflo(hp.x), bfhi(hp.x), bflo(hp.y), bfhi(hp.y)}; } }
        if (HAS_RES) {
            f32x4 y[8]; float ss = 0.f; u32x2 p1[8];
#pragma unroll
            for (int j = 0; j < 8; ++j) p1[j] = (u32x2){0u, 0u};
            if (m0 >= 8192) {
#pragma unroll
                for (int j = 0; j < 8; ++j) p1[j] = ldg<u32x2>(Y + (size_t)MTOK * DM + (size_t)m * DM + j * 256 + X.lane * 4); }
#pragma unroll
            for (int j = 0; j < 8; ++j) { const u32x2 p0 = ldg<u32x2>(Y + (size_t)m * DM + j * 256 + X.lane * 4);
                y[j] = (f32x4){bflo(p0.x) + bflo(p1[j].x), bfhi(p0.x) + bfhi(p1[j].x), bflo(p0.y) + bflo(p1[j].y), bfhi(p0.y) + bfhi(p1[j].y)}; ss += (y[j][0] * y[j][0] + y[j][1] * y[j][1]) + (y[j][2] * y[j][2] + y[j][3] * y[j][3]); }
            const float r = 1.0f / sqrtf(wave_sum(ss, X.lane) * (1.0f / DM) + EPS);
#pragma unroll
            for (int j = 0; j < 8; ++j) { const int c = j * 256 + X.lane * 4;
                const f32x4 gt = *(const LAS f32x4*)(Lg + 2 * DM + c), gp = *(const LAS f32x4*)(Lg + c);
                h[j] = h[j] + (gt * wres) * (y[j] * r * gp);
                if (HOUT_F32) stg<f32x4>(hout + (size_t)m * DM + c, h[j]);
                else { u32x2 hw; hw.x = pk2(h[j][0], h[j][1]); hw.y = pk2(h[j][2], h[j][3]); stg<u32x2>(Hb + (size_t)m * DM + c, hw); } }
        }
        if (HAS_U) {
            float ss = 0.f;
#pragma unroll
            for (int j = 0; j < 8; ++j) ss += (h[j][0] * h[j][0] + h[j][1] * h[j][1]) + (h[j][2] * h[j][2] + h[j][3] * h[j][3]);
            const float r = 1.0f / sqrtf(wave_sum(ss, X.lane) * (1.0f / DM) + EPS);
#pragma unroll
            for (int j = 0; j < 8; ++j) { const int c = j * 256 + X.lane * 4;
                const f32x4 sh = *(const LAS f32x4*)(Lg + 3 * DM + c), sc = *(const LAS f32x4*)(Lg + 4 * DM + c), gp = *(const LAS f32x4*)(Lg + DM + c);
                const f32x4 u = (h[j] * r * gp) * (sc + 1.0f) + sh;
                u32x2 w; w.x = pk2(u[0], u[1]); w.y = pk2(u[2], u[3]);
                stg<u32x2>(U + (size_t)m * DM + c, w); }
        }
    }
    __syncthreads();
}

__device__ __forceinline__ void ph_mixpost(const Ctx& X0) {
    const Ctx X = relaunder(X0);
    const bf16_t* P = (const bf16_t*)(X.ws + WS_P);
    bf16_t* Q = (bf16_t*)(X.ws + WS_Q); bf16_t* KP = (bf16_t*)(X.ws + WS_KP); bf16_t* VP = (bf16_t*)(X.ws + WS_VP);
    bf16_t* KS = (bf16_t*)(X.ws + WS_KS); bf16_t* VS = (bf16_t*)(X.ws + WS_VS); bf16_t* Dd = (bf16_t*)(X.ws + WS_D);
    const float* rc = (const float*)(X.ws + WS_ROPE); const float* rs = rc + 64 * 32;
    const float* qkg = X.in[I_QKG];
    const int hsel = X.lane >> 5, l32 = X.lane & 31, half = l32 >> 4, ii = (l32 & 15) * 2, dA = half * 64 + ii;
    const f32x2n gq1 = ldg<f32x2n>(qkg + dA), gq2 = ldg<f32x2n>(qkg + dA + 32), gk1 = ldg<f32x2n>(qkg + 128 + dA), gk2 = ldg<f32x2n>(qkg + 128 + dA + 32);
    for (int m = X.gw; m < MTOK; m += X.NGW) {
        const bool smp = m >= NP_TOK; const int mm = smp ? m - NP_TOK : m; const int L = smp ? 1024 : 256; const int t = mm & (L - 1); const int b = smp ? (mm >> 10) : (mm >> 8);
        const int seq_base = m - t;
        const bf16_t* prow = P + (size_t)m * MIXIN;
        f32x2n cs = {1.f, 1.f}, sn = {0.f, 0.f};
        if (smp) { const int pos = half == 0 ? (t >> 6) : (t & 63); cs = ldg<f32x2n>(rc + pos * 32 + ii); sn = ldg<f32x2n>(rs + pos * 32 + ii); }
        f32x2n xa[5], xb[5];
        unsigned ra[5], rb[5];
#pragma unroll
        for (int p = 0; p < 4; ++p) { const bf16_t* sp = prow + 1024 + (2 * p + hsel) * 128 + dA; ra[p] = ldg<unsigned>(sp); rb[p] = ldg<unsigned>(sp + 32); }
        const bf16_t* kp = prow + 2048 + hsel * 128 + dA;
        ra[4] = ldg<unsigned>(kp); rb[4] = ldg<unsigned>(kp + 32);
        const unsigned rva = ldg<unsigned>(kp + 256), rvb = ldg<unsigned>(kp + 256 + 32);
        u32x2 own[4], win[30];
#pragma unroll
        for (int g = 0; g < 4; ++g) {
            const int w = 2 << g; const int lo0 = t - w / 2;
            own[g] = ldg<u32x2>(prow + g * 256 + X.lane * 4);
#pragma unroll
            for (int k = 0; k < w; ++k) { const int tt = lo0 + k; const int tc = tt < 0 ? 0 : (tt >= L ? L - 1 : tt);
                win[w - 2 + k] = ldg<u32x2>(P + (size_t)(seq_base + tc) * MIXIN + g * 256 + X.lane * 4); }
        }
        __builtin_amdgcn_sched_barrier(0);
#pragma unroll
        for (int p = 0; p < 5; ++p) { xa[p] = (f32x2n){bflo(ra[p]), bfhi(ra[p])}; xb[p] = (f32x2n){bflo(rb[p]), bfhi(rb[p])}; }
        const f32x2n va = {bflo(rva), bfhi(rva)}, vb = {bflo(rvb), bfhi(rvb)};
        float ss[5];
#pragma unroll
        for (int p = 0; p < 5; ++p) ss[p] = (xa[p][0] * xa[p][0] + xa[p][1] * xa[p][1]) + (xb[p][0] * xb[p][0] + xb[p][1] * xb[p][1]);
#pragma unroll
        for (int o = 1; o < 32; o <<= 1)
#pragma unroll
            for (int p = 0; p < 5; ++p) ss[p] += lane_xor(ss[p], X.lane, o);
#pragma unroll
        for (int p = 0; p < 4; ++p) {
            const float r = 1.0f / sqrtf(ss[p] * (1.0f / 128.0f) + EPS);
            const f32x2n x1 = xa[p] * r * gq1, x2 = xb[p] * r * gq2;
            const f32x2n o1 = x1 * cs - x2 * sn, o2 = x2 * cs + x1 * sn;
            bf16_t* qd = Q + (size_t)m * 1024 + (2 * p + hsel) * 128 + dA;
            stg<unsigned>(qd, pkbf(o1[0], o1[1])); stg<unsigned>(qd + 32, pkbf(o2[0], o2[1]));
        }
        {
            const float r = 1.0f / sqrtf(ss[4] * (1.0f / 128.0f) + EPS);
            const f32x2n x1 = xa[4] * r * gk1, x2 = xb[4] * r * gk2;
            if (!smp) {
                float* ko = X.out + OUT_K + (size_t)m * 256 + hsel * 128 + dA; float* vo = X.out + OUT_V + (size_t)m * 256 + hsel * 128 + dA;
                stg<f32x2n>(ko, x1); stg<f32x2n>(ko + 32, x2); stg<f32x2n>(vo, va); stg<f32x2n>(vo + 32, vb);
                const size_t o = ((size_t)(b * 2 + hsel) * 256 + t) * 128 + dA;
                stg<unsigned>(KP + o, pkbf(x1[0], x1[1])); stg<unsigned>(KP + o + 32, pkbf(x2[0], x2[1]));
                stg<unsigned>(VP + o, rva); stg<unsigned>(VP + o + 32, rvb);
            } else {
                const f32x2n o1 = x1 * cs - x2 * sn, o2 = x2 * cs + x1 * sn;
                const size_t o = ((size_t)(b * 2 + hsel) * 1536 + 512 + t) * 128 + dA;
                stg<unsigned>(KS + o, pkbf(o1[0], o1[1])); stg<unsigned>(KS + o + 32, pkbf(o2[0], o2[1]));
                stg<unsigned>(VS + o, rva); stg<unsigned>(VS + o + 32, rvb);
            }
        }
#pragma unroll
        for (int g = 0; g < 4; ++g) {
            const int w = 2 << g; const int lo0 = t - w / 2;
            int lo = lo0, hi = lo0 + w; lo = lo < 0 ? 0 : lo; hi = hi > L ? L : hi;
            f32x4 s = {0.f, 0.f, 0.f, 0.f};
#pragma unroll
            for (int k = 0; k < w; ++k) { const int tt = lo0 + k; const bool ok = tt >= 0 && tt < L;
                const u32x2 wk = win[w - 2 + k]; s += ok ? (f32x4){bflo(wk.x), bfhi(wk.x), bflo(wk.y), bfhi(wk.y)} : (f32x4){0.f, 0.f, 0.f, 0.f}; }
            const float inv = 1.0f / (float)(hi - lo);
            const f32x4 d = s * inv - (f32x4){bflo(own[g].x), bfhi(own[g].x), bflo(own[g].y), bfhi(own[g].y)};
            u32x2 wv; wv.x = pk2(d[0], d[1]); wv.y = pk2(d[2], d[3]);
            stg<u32x2>(Dd + (size_t)m * 1024 + g * 256 + X.lane * 4, wv);
        }
    }
}

__device__ __forceinline__ void ph_conv(const Ctx& X0) {
    const Ctx X = relaunder(X0);
    const bf16_t* Z = (const bf16_t*)(X.ws + WS_ZXB); bf16_t* XBC = (bf16_t*)(X.ws + WS_XBC);
    const float* DT = (const float*)(X.ws + WS_DT); float* DTS = (float*)(X.ws + WS_DTS);
    const float* dtb = X.in[I_DTB];
    LAS float* cw = (LAS float*)X.lds; LAS float* cb = cw + CONVD * 3;
    for (int e = X.tid; e < CONVD * 3 / 4; e += NTHREADS) *(LAS f32x4*)(cw + e * 4) = ldg<f32x4>(X.in[I_CW] + e * 4);
    for (int e = X.tid; e < CONVD / 4; e += NTHREADS) *(LAS f32x4*)(cb + e * 4) = ldg<f32x4>(X.in[I_CB] + e * 4);
    __syncthreads();
    for (int m = X.gw; m < MTOK; m += X.NGW) {
        const bool smp = m >= NP_TOK; const int mm = smp ? m - NP_TOK : m; const int L = smp ? 1024 : 256; const int t = mm & (L - 1);
        const bool hasm = t > 0, hasp = t < L - 1;
        const bf16_t* r0 = Z + (size_t)m * ZXB_LD + 4096 + X.lane * 8;
        const bf16_t* rm = hasm ? r0 - ZXB_LD : r0; const bf16_t* rp = hasp ? r0 + ZXB_LD : r0;
        const u32x4 z4 = {0u, 0u, 0u, 0u};
#pragma unroll 1
        for (int ib = 0; ib < 3; ++ib) {
            u32x4 x0[4], xm[4], xp[4];
#pragma unroll
            for (int k = 0; k < 4; ++k) { const int cc = (ib * 4 + k) * 512; x0[k] = ldg<u32x4>(r0 + cc); xm[k] = ldg<u32x4>(rm + cc); xp[k] = ldg<u32x4>(rp + cc); }
#pragma unroll
            for (int k = 0; k < 4; ++k) {
                const int c0 = (ib * 4 + k) * 512 + X.lane * 8;
                const u32x4 vm = hasm ? xm[k] : z4, vp = hasp ? xp[k] : z4;
                float wv[24], bv[8];
#pragma unroll
                for (int q = 0; q < 6; ++q) { const f32x4 t4 = *(const LAS f32x4*)(cw + c0 * 3 + q * 4); wv[q * 4] = t4[0]; wv[q * 4 + 1] = t4[1]; wv[q * 4 + 2] = t4[2]; wv[q * 4 + 3] = t4[3]; }
#pragma unroll
                for (int q = 0; q < 2; ++q) { const f32x4 t4 = *(const LAS f32x4*)(cb + c0 + q * 4); bv[q * 4] = t4[0]; bv[q * 4 + 1] = t4[1]; bv[q * 4 + 2] = t4[2]; bv[q * 4 + 3] = t4[3]; }
                float o[8];
#pragma unroll
                for (int j = 0; j < 8; ++j) {
                    const unsigned wm = vm[j >> 1], w0 = x0[k][j >> 1], wp = vp[j >> 1];
                    const float am = (j & 1) ? bfhi(wm) : bflo(wm), a0 = (j & 1) ? bfhi(w0) : bflo(w0), ap = (j & 1) ? bfhi(wp) : bflo(wp);
                    o[j] = silu_f(am * wv[j * 3] + a0 * wv[j * 3 + 1] + ap * wv[j * 3 + 2] + bv[j]);
                }
                u32x4 w; w.x = pk2(o[0], o[1]); w.y = pk2(o[2], o[3]); w.z = pk2(o[4], o[5]); w.w = pk2(o[6], o[7]);
                stg<u32x4>(XBC + (size_t)m * CONVD + c0, w);
            }
        }
#pragma unroll
        for (int jj = 0; jj < 2; ++jj) { const int j = X.lane + 64 * jj; const float v = DT[(size_t)m * 128 + j] + dtb[j];
            DTS[(size_t)m * 128 + j] = fmaxf(v, 0.f) + log1pf(__expf(-fabsf(v))); }
    }
}

namespace ssd {
using s16x4 = __attribute__((ext_vector_type(4))) short;
__device__ __forceinline__ s16x4 tr_read(const LAS unsigned char* p) { return __builtin_amdgcn_ds_read_tr16_b64_v4i16((LAS s16x4*)p); }
__device__ __forceinline__ void glds16(const void* gsrc, unsigned lds_dst) { unsigned keep;
    asm volatile("s_mov_b32 %0, m0\n\ts_mov_b32 m0, %2\n\ts_nop 0\n\tglobal_load_lds_dwordx4 %1, off\n\ts_mov_b32 m0, %0" : "=&s"(keep) : "v"(gsrc), "s"(lds_dst) : "memory"); }
__device__ __forceinline__ f32x4 mfma16(bf16x8 a, bf16x8 b, f32x4 c) { return __builtin_amdgcn_mfma_f32_16x16x32_bf16(a, b, c, 0, 0, 0); }
__device__ __forceinline__ unsigned cvtpk(float lo, float hi) { return pkbf(lo, hi); }
}
__device__ __forceinline__ void ph_ssd(const Ctx& X0) {
    const Ctx X = relaunder(X0);
    const bf16_t* XBC = (const bf16_t*)(X.ws + WS_XBC); const float* DTS = (const float*)(X.ws + WS_DTS);
    LAS unsigned char* L = (LAS unsigned char*)X.lds;
    const unsigned Lb = (unsigned)(uintptr_t)L;
    const int lane = X.lane, w = X.wave, q = lane >> 4, r16 = lane & 15, li = lane & 31;
    const int hl = w >> 1, ph = w & 1;
    LAS float* arr0 = (LAS float*)(L + 65536 + w * 1024);
    const int trq = (lane & 15) >> 2, trp = lane & 3;
    const int trrow = 4 * q + trq;
    const bool isx = w >= 4;
    const int dstw = isx ? 16384 + (w - 4) * 4096 : (w >> 1) * 8192 + (w & 1) * 4096;
    unsigned voff[4];
#pragma unroll
    for (int k = 0; k < 4; ++k) { const int row = isx ? 8 * (w - 4) + 2 * k + (lane >> 5) : 16 * (w & 1) + 4 * k + (lane >> 4);
        const int c = isx ? ((lane & 31) ^ (row & 15)) : ((lane & 15) ^ (row & 15)); voff[k] = (unsigned)(row * CONVD + c * 8) * 2u; }
    for (int it = X.bid; it < 768; it += X.G) {
        const bool smp = it < 256; const int v = smp ? it : it - 256;
        const int bq = v >> 5, rest = v & 31, g = rest >> 2, gh = (rest >> 1) & 1, d_rt = rest & 1;
#pragma unroll
      for (int D = 0; D < 2; ++D) {
        if (d_rt != D) continue;
        const int d = D;
        const int bg = smp ? 16 + bq : bq;
        const int Lseq = smp ? 1024 : 256; const int base = smp ? NP_TOK + bq * 1024 : bq * 256;
        const int h = 8 * g + 4 * gh + hl;
        const float A = -__expf(X.in[I_ALOG][d * 64 + h]);
        const float dskip = d == 0 ? X.in[I_SD][h] + X.in[I_SD][64 + h] : 0.f;
        bf16_t* Yd = (bf16_t*)(X.ws + (d ? WS_YB : WS_YF));
        f32x4 hT[8][2];
        if (smp) { const float* s0 = X.in[I_ST] + (((size_t)bq * 2 + d) * 64 + h) * 8192;
#pragma unroll
            for (int nt = 0; nt < 8; ++nt)
#pragma unroll
                for (int pt = 0; pt < 2; ++pt) hT[nt][pt] = ldg<f32x4>(s0 + (size_t)(32 * ph + 16 * pt + r16) * 128 + 16 * nt + 4 * q); }
        else {
#pragma unroll
            for (int nt = 0; nt < 8; ++nt)
#pragma unroll
                for (int pt = 0; pt < 2; ++pt) hT[nt][pt] = (f32x4){0.f, 0.f, 0.f, 0.f}; }
        const int nsteps = Lseq >> 5;
        const unsigned ylane = (unsigned)((4 * q) * DINNER + 32 * ph + r16) * 2u;
        const int colbase = isx ? (8 * g + 4 * gh) * 64 : ((w >> 1) ? 4096 : 5120) + g * 128;
#define SSD_ISSUE(t0_, b_) do { const char* sb_ = (const char*)(XBC + (size_t)(base + (t0_)) * CONVD + colbase); \
            _Pragma("unroll") for (int k_ = 0; k_ < 4; ++k_) ssd::glds16(sb_ + voff[k_], Lb + (unsigned)((b_) * 32768 + dstw + k_ * 1024)); } while (0)
#define SSD_SCAN(dtv_, par_, tot_) do { float a_ = (dtv_) * A; \
            _Pragma("unroll") for (int o_ = 1; o_ < 32; o_ <<= 1) { const int src_ = d == 0 ? li - o_ : li + o_; \
                const float t_ = __builtin_bit_cast(float, __builtin_amdgcn_ds_bpermute(((lane & 32) | (src_ & 31)) << 2, __builtin_bit_cast(int, a_))); \
                if (src_ >= 0 && src_ < 32) a_ += t_; } \
            (tot_) = __builtin_bit_cast(float, d == 0 ? __builtin_amdgcn_readlane(__builtin_bit_cast(int, a_), 31) : __builtin_amdgcn_readlane(__builtin_bit_cast(int, a_), 0)); \
            LAS float* ar_ = arr0 + (par_) * 128; ar_[li] = a_; ar_[32 + li] = __expf(a_); ar_[64 + li] = (dtv_) * __expf((tot_) - a_); ar_[96 + li] = (dtv_); } while (0)
        float tot_cur;
        { const int t0 = d == 0 ? 0 : Lseq - 32; SSD_ISSUE(t0, 0); const float dt0 = ldg<float>(DTS + (size_t)(base + t0 + li) * 128 + d * 64 + h); SSD_SCAN(dt0, 0, tot_cur); }
        for (int s2 = 0; s2 < nsteps; s2 += 2) {
#pragma unroll
          for (int par = 0; par < 2; ++par) {
            const int s = s2 + par;
            const int t0 = d == 0 ? s * 32 : Lseq - 32 - s * 32;
            if (s == 0) asm volatile("s_waitcnt vmcnt(0)" ::: "memory"); else asm volatile("s_waitcnt vmcnt(16)" ::: "memory");
            __syncthreads(); asm volatile("" ::: "memory");
            float dt_nx = 0.f;
            if (s + 1 < nsteps) { const int t1 = d == 0 ? t0 + 32 : t0 - 32; SSD_ISSUE(t1, par ^ 1); dt_nx = ldg<float>(DTS + (size_t)(base + t1 + li) * 128 + d * 64 + h); }
            LAS float* a_s = arr0 + par * 128; LAS float* ea_s = a_s + 32; LAS float* sc_s = a_s + 64; LAS float* dt_s = a_s + 96;
            const float tot = tot_cur;
            LAS unsigned char* Bf = L + par * 32768;
            f32x4 cbt[2][2];
#pragma unroll
            for (int jt = 0; jt < 2; ++jt)
#pragma unroll
                for (int it2 = 0; it2 < 2; ++it2) cbt[jt][it2] = (f32x4){0.f, 0.f, 0.f, 0.f};
#pragma unroll
            for (int ks = 0; ks < 4; ++ks) {
                bf16x8 af[2], bfr[2];
#pragma unroll
                for (int t = 0; t < 2; ++t) { const int off = (16 * t + r16) * 256 + (((4 * ks + q) ^ r16) << 4);
                    af[t] = *(const LAS bf16x8*)(Bf + 8192 + off); bfr[t] = *(const LAS bf16x8*)(Bf + off); }
#pragma unroll
                for (int jt = 0; jt < 2; ++jt)
#pragma unroll
                    for (int it2 = 0; it2 < 2; ++it2) if (!(d == 0 ? (jt == 1 && it2 == 0) : (jt == 0 && it2 == 1))) cbt[jt][it2] = ssd::mfma16(af[jt], bfr[it2], cbt[jt][it2]);
            }
            f32x4 y[2][2];
#pragma unroll
            for (int it2 = 0; it2 < 2; ++it2)
#pragma unroll
                for (int pt = 0; pt < 2; ++pt) y[it2][pt] = (f32x4){0.f, 0.f, 0.f, 0.f};
#pragma unroll
            for (int ks = 0; ks < 4; ++ks) {
                bf16x8 ca[2], hb[2];
#pragma unroll
                for (int it2 = 0; it2 < 2; ++it2) { const int rowb = (16 * it2 + r16) * 256 + 8 * (q & 1);
                    const u32x2 lo = *(const LAS u32x2*)(Bf + rowb + (((4 * ks + (q >> 1)) ^ r16) << 4)), hi2 = *(const LAS u32x2*)(Bf + rowb + (((4 * ks + 2 + (q >> 1)) ^ r16) << 4));
                    u32x4 wv = {lo.x, lo.y, hi2.x, hi2.y}; ca[it2] = __builtin_bit_cast(bf16x8, wv); }
#pragma unroll
                for (int pt = 0; pt < 2; ++pt) { const f32x4 h0 = hT[2 * ks][pt], h1 = hT[2 * ks + 1][pt];
                    u32x4 wv = {ssd::cvtpk(h0[0], h0[1]), ssd::cvtpk(h0[2], h0[3]), ssd::cvtpk(h1[0], h1[1]), ssd::cvtpk(h1[2], h1[3])}; hb[pt] = __builtin_bit_cast(bf16x8, wv); }
#pragma unroll
                for (int it2 = 0; it2 < 2; ++it2)
#pragma unroll
                    for (int pt = 0; pt < 2; ++pt) y[it2][pt] = ssd::mfma16(ca[it2], hb[pt], y[it2][pt]);
            }
#pragma unroll
            for (int it2 = 0; it2 < 2; ++it2) { const f32x4 ea4 = *(const LAS f32x4*)(ea_s + 16 * it2 + 4 * q);
#pragma unroll
                for (int pt = 0; pt < 2; ++pt) y[it2][pt] = y[it2][pt] * ea4; }
            bf16x8 xf[2];
            {
                ssd::s16x4 x0[2], x1[2];
#pragma unroll
                for (int pt = 0; pt < 2; ++pt) { const int ch = hl * 8 + ph * 4 + 2 * pt + (trp >> 1);
                    const LAS unsigned char* ad = Bf + 16384 + (trrow * 512 + ((ch ^ (trrow & 15)) << 4) + 8 * (trp & 1));
                    x0[pt] = ssd::tr_read(ad); x1[pt] = ssd::tr_read(ad + 16 * 512); }
#pragma unroll
                for (int pt = 0; pt < 2; ++pt) xf[pt] = (bf16x8){x0[pt][0], x0[pt][1], x0[pt][2], x0[pt][3], x1[pt][0], x1[pt][1], x1[pt][2], x1[pt][3]};
            }
            const f32x4 aj0 = *(const LAS f32x4*)(a_s + 4 * q), aj1 = *(const LAS f32x4*)(a_s + 16 + 4 * q);
            const f32x4 dj0 = *(const LAS f32x4*)(dt_s + 4 * q), dj1 = *(const LAS f32x4*)(dt_s + 16 + 4 * q);
            int r16m = r16; asm volatile("" : "+v"(r16m));
            const int sgn = d == 0 ? 1 : -1;
            const int dq = d == 0 ? 4 * q - r16m : r16m - 4 * q;
#pragma unroll
            for (int it2 = 0; it2 < 2; ++it2) {
                const int i = 16 * it2 + r16m; const float ai = a_s[i];
                float wv[8];
#pragma unroll
                for (int e = 0; e < 4; ++e) {
                    const bool m0 = dq <= sgn * (16 * it2 - e), m1 = dq <= sgn * (16 * it2 - 16 - e);
                    const bool z0 = d == 1 && it2 == 1, f0 = d == 0 && it2 == 1, z1 = d == 0 && it2 == 0, f1 = d == 1 && it2 == 0;
                    wv[e] = z0 ? 0.f : ((f0 || m0) ? cbt[0][it2][e] * __expf(ai - aj0[e]) * dj0[e] : 0.f);
                    wv[4 + e] = z1 ? 0.f : ((f1 || m1) ? cbt[1][it2][e] * __expf(ai - aj1[e]) * dj1[e] : 0.f);
                }
                u32x4 ww = {ssd::cvtpk(wv[0], wv[1]), ssd::cvtpk(wv[2], wv[3]), ssd::cvtpk(wv[4], wv[5]), ssd::cvtpk(wv[6], wv[7])};
                const bf16x8 wf = __builtin_bit_cast(bf16x8, ww);
#pragma unroll
                for (int pt = 0; pt < 2; ++pt) y[it2][pt] = ssd::mfma16(wf, xf[pt], y[it2][pt]);
            }
#pragma unroll
            for (int pt = 0; pt < 2; ++pt) { const u32x4 xw = __builtin_bit_cast(u32x4, xf[pt]);
                y[0][pt] += dskip * (f32x4){bflo(xw.x), bfhi(xw.x), bflo(xw.y), bfhi(xw.y)}; y[1][pt] += dskip * (f32x4){bflo(xw.z), bfhi(xw.z), bflo(xw.w), bfhi(xw.w)}; }
            char* yst = (char*)Yd + ((size_t)(base + t0) * DINNER + h * 64) * 2;
            unsigned yl = ylane; asm volatile("" : "+v"(yl));
#pragma unroll
            for (int it2 = 0; it2 < 2; ++it2)
#pragma unroll
                for (int pt = 0; pt < 2; ++pt)
#pragma unroll
                    for (int r = 0; r < 4; r += 2) { const unsigned pk = pkbf(y[it2][pt][r], y[it2][pt][r + 1]);
                        stg<bf16_t>(yst + (yl + (unsigned)(((16 * it2 + r) * DINNER + 16 * pt) * 2)), (bf16_t)(pk & 0xffffu));
                        stg<bf16_t>(yst + (yl + (unsigned)(((16 * it2 + r + 1) * DINNER + 16 * pt) * 2)), (bf16_t)(pk >> 16)); }
            {
                const f32x4 s0 = *(const LAS f32x4*)(sc_s + 4 * q), s1 = *(const LAS f32x4*)(sc_s + 16 + 4 * q);
                bf16x8 xs[2];
#pragma unroll
                for (int pt = 0; pt < 2; ++pt) { const u32x4 xw = __builtin_bit_cast(u32x4, xf[pt]);
                    u32x4 o; o.x = ssd::cvtpk(bflo(xw.x) * s0[0], bfhi(xw.x) * s0[1]); o.y = ssd::cvtpk(bflo(xw.y) * s0[2], bfhi(xw.y) * s0[3]);
                    o.z = ssd::cvtpk(bflo(xw.z) * s1[0], bfhi(xw.z) * s1[1]); o.w = ssd::cvtpk(bflo(xw.w) * s1[2], bfhi(xw.w) * s1[3]); xs[pt] = __builtin_bit_cast(bf16x8, o); }
                const float et = __expf(tot);
#pragma unroll
                for (int nh = 0; nh < 2; ++nh) {
                    ssd::s16x4 b0[4], b1[4];
#pragma unroll
                    for (int k = 0; k < 4; ++k) { const int nt = nh * 4 + k; const int ch = 2 * nt + (trp >> 1);
                        const LAS unsigned char* ad = Bf + 8192 + (trrow * 256 + ((ch ^ (trrow & 15)) << 4) + 8 * (trp & 1));
                        b0[k] = ssd::tr_read(ad); b1[k] = ssd::tr_read(ad + 16 * 256); }
#pragma unroll
                    for (int k = 0; k < 4; ++k) { const int nt = nh * 4 + k;
                        const bf16x8 bt = (bf16x8){b0[k][0], b0[k][1], b0[k][2], b0[k][3], b1[k][0], b1[k][1], b1[k][2], b1[k][3]};
#pragma unroll
                        for (int pt = 0; pt < 2; ++pt) hT[nt][pt] = ssd::mfma16(bt, xs[pt], hT[nt][pt] * et); }
                }
            }
            if (s + 1 < nsteps) { float tn; SSD_SCAN(dt_nx, par ^ 1, tn); tot_cur = tn; }
          }
        }
#undef SSD_ISSUE
#undef SSD_SCAN
        if (!smp) { float* so = X.out + OUT_SSM + (((size_t)bg * 2 + d) * 64 + h) * 8192;
#pragma unroll
            for (int nt = 0; nt < 8; ++nt)
#pragma unroll
                for (int pt = 0; pt < 2; ++pt) stg<f32x4>(so + (size_t)(32 * ph + 16 * pt + r16) * 128 + 16 * nt + 4 * q, hT[nt][pt]); }
        __syncthreads();
      }
    }
}

__device__ __forceinline__ void ph_gatenorm(const Ctx& X0) {
    const Ctx X = relaunder(X0);
    const bf16_t* YF = (const bf16_t*)(X.ws + WS_YF); const bf16_t* YB = (const bf16_t*)(X.ws + WS_YB);
    const bf16_t* Z = (const bf16_t*)(X.ws + WS_ZXB);
    bf16_t* YN = (bf16_t*)(X.ws + WS_HID); const float* ng = X.in[I_SNG] + X.lane * 8;
    LAS float* yb = (LAS float*)((LAS unsigned char*)X.lds + X.wave * 16384) + X.lane * 8;
    f32x4 gv[16];
#pragma unroll
    for (int j = 0; j < 8; ++j) { gv[2 * j] = ldg<f32x4>(ng + j * 512); gv[2 * j + 1] = ldg<f32x4>(ng + j * 512 + 4); }
    for (int m = X.gw; m < MTOK; m += X.NGW) {
        const bf16_t* fp = YF + (size_t)m * DINNER + X.lane * 8; const bf16_t* bp = YB + (size_t)m * DINNER + X.lane * 8;
        const bf16_t* zp = Z + (size_t)m * ZXB_LD + X.lane * 8;
        float ss = 0.f;
        u32x4 fa[8], ba[8], za[8];
#pragma unroll
        for (int j = 0; j < 8; ++j) { fa[j] = ldg<u32x4>(fp + j * 512); ba[j] = ldg<u32x4>(bp + j * 512); za[j] = ldg<u32x4>(zp + j * 512); }
        __builtin_amdgcn_sched_barrier(0);
#pragma unroll
        for (int j = 0; j < 8; ++j) {
            const u32x4 f = fa[j], b = ba[j], z = za[j];
            float y[8];
#pragma unroll
            for (int k = 0; k < 4; ++k) {
                y[2 * k] = (bflo(f[k]) + bflo(b[k])) * silu_f(bflo(z[k]));
                y[2 * k + 1] = (bfhi(f[k]) + bfhi(b[k])) * silu_f(bfhi(z[k]));
                ss += y[2 * k] * y[2 * k] + y[2 * k + 1] * y[2 * k + 1]; }
            *(LAS f32x4*)(yb + j * 512) = (f32x4){y[0], y[1], y[2], y[3]}; *(LAS f32x4*)(yb + j * 512 + 4) = (f32x4){y[4], y[5], y[6], y[7]};
        }
        const float r = 1.0f / sqrtf(wave_sum(ss, X.lane) * (1.0f / DINNER) + EPS);
#pragma unroll
        for (int j = 0; j < 8; ++j) {
            const f32x4 g0 = gv[2 * j], g1 = gv[2 * j + 1];
            const f32x4 y0 = *(const LAS f32x4*)(yb + j * 512), y1 = *(const LAS f32x4*)(yb + j * 512 + 4);
            u32x4 o; o.x = pk2(y0[0] * r * g0[0], y0[1] * r * g0[1]); o.y = pk2(y0[2] * r * g0[2], y0[3] * r * g0[3]);
            o.z = pk2(y1[0] * r * g1[0], y1[1] * r * g1[1]); o.w = pk2(y1[2] * r * g1[2], y1[3] * r * g1[3]);
            stg<u32x4>(YN + (size_t)m * DINNER + j * 512 + X.lane * 8, o); }
    }
}

__device__ __forceinline__ void ph_attn(const Ctx& X0) {
    const Ctx X = relaunder(X0);
    const bf16_t* Q = (const bf16_t*)(X.ws + WS_Q); bf16_t* CAT = (bf16_t*)(X.ws + WS_CAT);
    const bf16_t* KP = (const bf16_t*)(X.ws + WS_KP); const bf16_t* VP = (const bf16_t*)(X.ws + WS_VP);
    const bf16_t* KS = (const bf16_t*)(X.ws + WS_KS); const bf16_t* VS = (const bf16_t*)(X.ws + WS_VS);
    for (int u = X.bid; u < 256 + 128; u += X.G) {
        const bool smp = u < 256; const int v = u - 256;
        const int b = smp ? (u >> 5) : (v >> 3), hh = smp ? ((u & 31) >> 2) : (v & 7), qb = smp ? (u & 3) : 0, kvh = hh >> 2;
        const size_t row0 = smp ? (size_t)NP_TOK + b * 1024 + qb * 256 : (size_t)b * 256;
        const int seq = smp ? 1536 : 256;
        const size_t kv0 = (size_t)(b * 2 + kvh) * seq * 128;
        const bf16_t* Kb = (smp ? KS : KP) + kv0; const bf16_t* Vb = (smp ? VS : VP) + kv0;
        att::attn_body<1024, 128, 2048>(Q + row0 * 1024 + hh * 128, Kb, Vb, CAT + row0 * 2048 + 1024 + hh * 128, seq, (LAS char*)X.lds, X.tid);
        __syncthreads();
    }
}

struct PhState { int pid, lo, hi; XcdBarrier bar; };
#define PH_BEGIN if (P.pid >= P.lo && P.pid < P.hi) { const Ctx XP = relaunder(X); (void)XP;
#define PH_END   if (P.pid + 1 < P.hi) xcd_barrier(P.bar, XP.tid == 0); } ++P.pid;
template <int L, int F>
__device__ __forceinline__ void sub_layer(const Ctx& X, PhState& P) {
    LAS unsigned char* lds3 = (LAS unsigned char*)X.lds;
    float* MODS = (float*)(X.ws + WS_MODS);
    bf16_t* H = (bf16_t*)(X.ws + WS_H); bf16_t* YB16 = (bf16_t*)(X.ws + WS_Y); const bf16_t* Y = YB16; bf16_t* U = (bf16_t*)(X.ws + WS_U); bf16_t* HID = (bf16_t*)(X.ws + WS_HID);
    const float* NG = X.in[I_NG];
        const float* mods = MODS + (size_t)L * 9 * NMODS;
        const float* ng = NG + (size_t)L * 6 * DM;
            PH_BEGIN {
                pg8::Gemm g{U, (const bf16_t*)(XP.ws + WS_W1T) + (size_t)(L * 2 + F) * 2 * DFF * DM, MTOK, 2 * DFF, DM, DM, DM, 0, 2 * DFF / 256, 0};
                pg8::StaticOrder S; S.init(MTOK, 2 * DFF, XP.G, XP.bid);
                pg8::EpiSwiGLU E{HID, DFF};
                pg8::gemm_phase(lds3, g, S, E, XP.tid);
                if constexpr (L == 0 && F == 0) conv_tail(XP, (MTOK / 256) * (2 * DFF / 256), CVQ0, CVQ1);
                if constexpr (L == 0 && F == 1) conv_tail(XP, (MTOK / 256) * (2 * DFF / 256), CVQ2, CVQ3);
                if constexpr (L == 1 && F == 0) conv_tail(XP, (MTOK / 256) * (2 * DFF / 256), CVQ3, CVQ4);
                if constexpr (L == 1 && F == 1) conv_tail(XP, (MTOK / 256) * (2 * DFF / 256), CVQ5, CV_TOTAL);
            } PH_END
            PH_BEGIN {
                pg8::Gemm g{HID, (const bf16_t*)(XP.ws + WS_W2T) + (size_t)(L * 2 + F) * DM * DFF, MTOK, 2 * DM, DFF / 2, DFF, DFF, 0, DM / 256, (size_t)DFF};
                pg8::MixedOrder S; S.init(XP.G, XP.bid);
                pg8::EpiBf16Part E{YB16, DM, (size_t)MTOK * DM, DM / 256};
                pg8::gemm_phase(lds3, g, S, E, XP.tid);
            } PH_END
            if constexpr (F == 0) {
                PH_BEGIN {
                    ph_row<true, true, L == 0, false>(X, XP.in[I_XP], XP.in[I_XS], nullptr, H, Y, 0.5f, mods + 2 * DM, ng + 1 * DM, mods + 3 * DM, mods + 4 * DM, ng + 2 * DM, U);
                } PH_END
                if constexpr (L == 0) {
                    PH_BEGIN {
                        pg8::Gemm g{U, (const bf16_t*)(XP.ws + WS_WMI), MTOK, MIXIN, DM, DM, DM, 0, MIXIN / 256, 0};
                        pg8::StaticOrder S; S.init(MTOK, MIXIN, XP.G, XP.bid);
                        pg8::EpiBf16S E{(bf16_t*)(XP.ws + WS_P), MIXIN, nullptr};
                        pg8::gemm_phase(lds3, g, S, E, XP.tid);
                        conv_tail(XP, (MTOK / 256) * (MIXIN / 256), CVQ1, CVQ2);
                    } PH_END
                    PH_BEGIN ph_mixpost(X); PH_END
                    PH_BEGIN {
                        ph_attn(X);
                    }
                    {
                        const Ctx XP = relaunder(X);
                        pg8::Gemm g{(const bf16_t*)(XP.ws + WS_D), (const bf16_t*)(XP.ws + WS_WPL), MTOK, 1024, 256, 1024, 256, 512, 4, 0};
                        pg8::StaticOrder S; S.init(MTOK, 1024, XP.G, XP.G - 1 - XP.bid);
                        pg8::EpiBf16S E{(bf16_t*)(XP.ws + WS_CAT), DM, XP.in[I_PS]};
                        pg8::gemm_phase(lds3, g, S, E, XP.tid);
                    }
                    if (P.pid + 1 < P.hi) { const Ctx XB = relaunder(X); xcd_barrier(P.bar, XB.tid == 0); } } ++P.pid;
                    PH_BEGIN {
                        pg8::Gemm g{(const bf16_t*)(XP.ws + WS_CAT), (const bf16_t*)(XP.ws + WS_WMO), MTOK, 2 * DM, DM / 2, DM, DM, 0, DM / 256, (size_t)DM};
                        pg8::MixedOrder S; S.init(XP.G, XP.bid);
                        pg8::EpiBf16Part E{YB16, DM, (size_t)MTOK * DM, DM / 256};
                        pg8::gemm_phase(lds3, g, S, E, XP.tid);
                    } PH_END
                } else {
                    PH_BEGIN {
                        pg8::Gemm g{U, (const bf16_t*)(XP.ws + WS_WSI), MTOK, SSMIN_PAD, DM, DM, DM, 0, SSMIN_PAD / 256, 0};
                        pg8::StaticOrder S; S.init(MTOK, SSMIN_PAD, XP.G, XP.bid);
                        pg8::EpiSsmIn E{(bf16_t*)(XP.ws + WS_ZXB), (float*)(XP.ws + WS_DT)};
                        pg8::gemm_phase(lds3, g, S, E, XP.tid);
                        conv_tail(XP, (MTOK / 256) * (SSMIN_PAD / 256), CVQ4, CVQ5);
                    } PH_END
                    PH_BEGIN ph_conv(X); PH_END
                    PH_BEGIN ph_ssd(X); PH_END
                    PH_BEGIN ph_gatenorm(X); PH_END
                    PH_BEGIN {
                        pg8::Gemm g{HID, (const bf16_t*)(XP.ws + WS_WSO), MTOK, 2 * DM, DINNER / 2, DINNER, DINNER, 0, DM / 256, (size_t)DINNER};
                        pg8::MixedOrder S; S.init(XP.G, XP.bid);
                        pg8::EpiBf16Part E{YB16, DM, (size_t)MTOK * DM, DM / 256};
                        pg8::gemm_phase(lds3, g, S, E, XP.tid);
                    } PH_END
                }
                PH_BEGIN ph_row<true, true, false, false>(X, nullptr, nullptr, nullptr, H, Y, 1.0f, mods + 5 * DM, ng + 3 * DM, mods + 6 * DM, mods + 7 * DM, ng + 4 * DM, U); PH_END
            } else {
                if constexpr (L == 0) {
                    PH_BEGIN ph_row<true, true, false, false>(X, nullptr, nullptr, nullptr, H, Y, 0.5f, mods + 8 * DM, ng + 5 * DM,
                                                MODS + (size_t)9 * NMODS + 0 * DM, MODS + (size_t)9 * NMODS + 1 * DM, NG + (size_t)6 * DM, U); PH_END
                } else {
                    PH_BEGIN ph_row<true, false, false, true>(X, nullptr, nullptr, X.out, H, Y, 0.5f, mods + 8 * DM, ng + 5 * DM, nullptr, nullptr, nullptr, nullptr); PH_END
                }
            }
}

__global__ void __launch_bounds__(NTHREADS, 2) fwd_kernel(Args args) {
    extern __shared__ __attribute__((aligned(16))) unsigned char lds[];
    Ctx X;
    X.tid = threadIdx.x; X.lane = X.tid & 63; X.wave = __builtin_amdgcn_readfirstlane(X.tid >> 6);
    X.G = gridDim.x; X.bid = blockIdx.x; X.gw = blockIdx.x * NWAVES + X.wave; X.NGW = X.G * NWAVES;
    X.ws = args.ws; X.in = (KinPtr)__builtin_amdgcn_kernarg_segment_ptr(); X.out = args.out; X.lds = lds;
    LAS unsigned char* lds3 = (LAS unsigned char*)lds;
    for (int u = X.tid; u < (LDS_BYTES - LDSCTL_OFF) / 4; u += NTHREADS) ((LAS unsigned*)(lds3 + LDSCTL_OFF))[u] = 0u;
    __syncthreads();
    const int lo = args.ph_lo, hi = args.ph_hi;
    const bool use_bar = (hi - lo) > 1;
    XcdBarrier bar; bar.bar = (unsigned*)(X.ws + WS_CTL) + CW_BAR; bar.x = 0; bar.st = nullptr;
    if (use_bar) bar = xcd_barrier_post((unsigned*)(X.ws + WS_CTL) + CW_BAR, (volatile LAS unsigned*)(lds3 + LDSCTL_OFF + 64));
    PhState P; P.pid = 0; P.lo = lo; P.hi = hi; P.bar = bar;

    float* MODS = (float*)(X.ws + WS_MODS);
    bf16_t* H = (bf16_t*)(X.ws + WS_H); bf16_t* YB16 = (bf16_t*)(X.ws + WS_Y); const bf16_t* Y = YB16; bf16_t* U = (bf16_t*)(X.ws + WS_U); bf16_t* HID = (bf16_t*)(X.ws + WS_HID);
    const float* NG = X.in[I_NG];

    PH_BEGIN ph_prologue(X); PH_END
    PH_BEGIN ph_row<false, true, true, false>(X, XP.in[I_XP], XP.in[I_XS], nullptr, nullptr, nullptr, 0.f, nullptr, nullptr, MODS + 0 * DM, MODS + 1 * DM, NG + 0 * DM, U); PH_END

    sub_layer<0, 0>(X, P); sub_layer<0, 1>(X, P); sub_layer<1, 0>(X, P); sub_layer<1, 1>(X, P);
#undef PH_BEGIN
#undef PH_END
}
constexpr int N_PHASES = 2 + (3 + 4 + 1 + 3) + (3 + 5 + 1 + 3);

extern "C" void kernel_launch(void* const* d_in, const int* in_sizes, int n_in, void* d_out, int out_size, void* d_ws, size_t ws_size, hipStream_t stream) {
    static int grid = 0;
    if (grid == 0) {
        if (n_in != 25 || out_size != OUT_TOTAL || ws_size < WS_END) { fprintf(stderr, "kernel_launch: unexpected shapes (n_in %d, out %d, ws %zu < %zu)\n", n_in, out_size, ws_size, (size_t)WS_END); grid = -1; return; }
        int dev = 0, cus = 0, per_cu = 0;
        if (hipGetDevice(&dev) != hipSuccess || hipDeviceGetAttribute(&cus, hipDeviceAttributeMultiprocessorCount, dev) != hipSuccess) { grid = -1; return; }
        if (hipFuncSetAttribute((const void*)fwd_kernel, hipFuncAttributeMaxDynamicSharedMemorySize, LDS_BYTES) != hipSuccess) { fprintf(stderr, "kernel_launch: hipFuncSetAttribute failed\n"); grid = -1; return; }
        if (hipOccupancyMaxActiveBlocksPerMultiprocessor(&per_cu, (const void*)fwd_kernel, NTHREADS, LDS_BYTES) != hipSuccess || per_cu < 1) { fprintf(stderr, "kernel_launch: occupancy query says %d\n", per_cu); }
        (void)hipGetLastError();
        grid = cus;
    }
    if (grid < 0) return;
    (void)hipMemsetAsync((char*)d_ws + WS_CTL, 0, CTL_ZERO_BYTES, stream);
    Args a{};
    for (int i = 0; i < 25; ++i) a.in[i] = (const float*)d_in[i];
    a.out = (float*)d_out; a.ws = (unsigned char*)d_ws;
#if MK_ONE_LAUNCH
    a.ph_lo = 0; a.ph_hi = N_PHASES;
    hipLaunchKernelGGL(fwd_kernel, dim3(grid), dim3(NTHREADS), LDS_BYTES, stream, a);
#else
    for (int p = 0; p < N_PHASES; ++p) { a.ph_lo = p; a.ph_hi = p + 1; hipLaunchKernelGGL(fwd_kernel, dim3(grid), dim3(NTHREADS), LDS_BYTES, stream, a); }
#endif
}
```
